# Optimizing an MI355X kernel written in HIP

```python
import math
import jax, jax.numpy as jnp
from jax import lax
import numpy as np

D_MODEL = 1024
BATCH = 8
SEQ = 2048
DEPTH = 2

GRID_W = 64
CTX_LEN = 256
N_HEADS_A = 4
DH_A = 64
DV_A = 2 * DH_A
WIDTH_A = N_HEADS_A * DV_A
N_HEADS_B = 4
DK_B = 64
DV_B = 64
WIDTH_BK = N_HEADS_B * DK_B
WIDTH_B = N_HEADS_B * DV_B
FN_GROUPS = 4
FN_GROUP_DIM = 64
WIDTH_C = FN_GROUPS * FN_GROUP_DIM
MIX_WIDTH = WIDTH_A + WIDTH_B + WIDTH_C
PROJ_SIZES = (WIDTH_A, WIDTH_A, WIDTH_A, WIDTH_BK, WIDTH_BK, WIDTH_BK, WIDTH_B, WIDTH_B, WIDTH_C)
PROJ_WIDTH = 3 * WIDTH_A + 3 * WIDTH_BK + 2 * WIDTH_B + WIDTH_C
D_FF = 2816
CONV_W = 3
Q_BLOCK = 128
CHUNK = 64
ROPE_BASE = 10000.0
EPS = 1e-6

kernel_name = 'hybrid_diffattn_hgrn2_fnet_convffn_dit'


def rms_norm(x, w):
    xf = x.astype(jnp.float32)
    y = xf * lax.rsqrt(jnp.mean(xf * xf, axis=-1, keepdims=True) + EPS)
    return (y * w.astype(jnp.float32)).astype(x.dtype)


def modulate(h, shift, scale):
    return h * (1 + scale) + shift


def flip(a):
    return jnp.flip(a, axis=1)


def axial_rope(rows):
    pos_r = jnp.repeat(jnp.arange(rows), GRID_W).astype(jnp.float32)
    pos_c = jnp.tile(jnp.arange(GRID_W), rows).astype(jnp.float32)
    half = DH_A // 2
    inv_freq = ROPE_BASE ** (-jnp.arange(0, half, 2, dtype=jnp.float32) / half)
    ang_r = pos_r[:, None] * inv_freq
    ang_c = pos_c[:, None] * inv_freq
    ang = jnp.concatenate([ang_r, ang_r, ang_c, ang_c], axis=-1)
    return jnp.cos(ang), jnp.sin(ang)


def _rotate_half(p):
    h = p.shape[-1] // 2
    return jnp.concatenate([-p[..., h:], p[..., :h]], axis=-1)


def apply_axial_rope(t, cos, sin):
    t_row, t_col = jnp.split(t, 2, axis=-1)
    rot = jnp.concatenate([_rotate_half(t_row), _rotate_half(t_col)], axis=-1)
    cos = cos[None, :, None, None, :]
    sin = sin[None, :, None, None, :]
    return (t * cos + rot * sin).astype(t.dtype)


def diff_attend(q, k, v, lam):
    s = jnp.einsum('bqhcd,bkhcd->bhcqk', q, k).astype(jnp.float32) * (DH_A ** -0.5)
    p = jax.nn.softmax(s, axis=-1)
    a = p[:, :, 0] - lam * p[:, :, 1]
    return jnp.einsum('bhqk,bkhd->bqhd', a, v.astype(jnp.float32))


def diff_attend_blocks(q, k, v, lam):
    b, l = q.shape[:2]
    nb = l // Q_BLOCK
    qb = q.reshape(b, nb, Q_BLOCK, N_HEADS_A, 2, DH_A).transpose(1, 0, 2, 3, 4, 5)
    o = lax.map(lambda blk: diff_attend(blk, k, v, lam), qb)
    return o.transpose(1, 0, 2, 3, 4).reshape(b, l, N_HEADS_A, DV_A)


def diff_head_norm(o, w, lam_init):
    b, l = o.shape[:2]
    return (rms_norm(o, w) * (1.0 - lam_init)).reshape(b, l, WIDTH_A)


def log_forget(z, lb):
    zf = z.astype(jnp.float32)
    return jnp.logaddexp(jnp.log(lb), jnp.log1p(-lb) + jax.nn.log_sigmoid(zf))


def hgrn_scan(q, k, v, logf, s0):
    b, l, h, _ = q.shape
    dv = v.shape[-1]
    nc = l // CHUNK

    def chunks(a):
        return a.reshape(b, nc, CHUNK, h, a.shape[-1]).transpose(1, 0, 3, 2, 4)

    lower = jnp.tril(jnp.ones((CHUNK, CHUNK), dtype=bool))[:, :, None]

    def step(state, blk):
        qc, kc, vc, gc = blk
        cum = jnp.cumsum(gc, axis=2)
        rel = jnp.where(lower, cum[:, :, :, None, :] - cum[:, :, None, :, :], -jnp.inf)
        scores = jnp.einsum('bhtd,bhsd,bhtsd->bhts', qc, kc, jnp.exp(rel))
        o = (jnp.einsum('bhts,bhsv->bhtv', scores, vc)
             + jnp.einsum('bhtd,bhdv->bhtv', qc * jnp.exp(cum), state))
        cum_end = cum[:, :, -1:, :]
        state = (jnp.exp(cum_end)[:, :, 0, :, None] * state
                 + jnp.einsum('bhsd,bhsv->bhdv', kc * jnp.exp(cum_end - cum), vc))
        return state, o

    state, o = lax.scan(step, s0, (chunks(q), chunks(k), chunks(v), chunks(logf)))
    return o.transpose(1, 0, 3, 2, 4).reshape(b, l, h, dv), state


def hgrn_final_state(k, v, logf):
    tail = flip(jnp.cumsum(flip(logf), axis=1)) - logf
    return jnp.einsum('blhk,blhv->bhkv', k * jnp.exp(tail), v)


def hgrn_bidir(m, s_fwd, s_bwd):
    o_f, st_f = hgrn_scan(m['qh'], m['kf'], m['vh'], m['gf'], s_fwd)
    o_b, st_b = hgrn_scan(flip(m['qh']), flip(m['kb']), flip(m['vh']), flip(m['gb']), s_bwd)
    return o_f + flip(o_b), st_f, st_b


def hgrn_out(o, og, w):
    b, l = o.shape[:2]
    return (rms_norm(o, w) * jax.nn.silu(og.astype(jnp.float32))).reshape(b, l, WIDTH_B)


def fourier_mix(u, w):
    b, l, _ = u.shape
    ug = u.astype(jnp.float32).reshape(b, l, FN_GROUPS, FN_GROUP_DIM)
    y = jnp.fft.fft2(ug, axes=(1, 3), norm='ortho').real.reshape(b, l, WIDTH_C)
    return y.astype(u.dtype) @ w


def conv_ffn(h, w_up, conv_w, conv_b, w_down):
    u = h @ w_up
    up = jnp.pad(u, ((0, 0), (1, 1), (0, 0)))
    u = up[:, :-2] * conv_w[0] + up[:, 1:-1] * conv_w[1] + up[:, 2:] * conv_w[2] + conv_b
    gate, val = jnp.split(u, 2, axis=-1)
    return (jax.nn.silu(gate) * val) @ w_down


def unpack(p, lb):
    b, l, _ = p.shape
    idx = np.cumsum(PROJ_SIZES)[:-1].tolist()
    qa, ka, va, qh, zf, zb, ih, gh, uf = jnp.split(p, idx, axis=-1)
    gf = log_forget(zf, lb[0]).reshape(b, l, N_HEADS_B, DK_B)
    gb = log_forget(zb, lb[1]).reshape(b, l, N_HEADS_B, DK_B)
    return {
        'qa': qa.reshape(b, l, N_HEADS_A, 2, DH_A),
        'ka': ka.reshape(b, l, N_HEADS_A, 2, DH_A),
        'va': va.reshape(b, l, N_HEADS_A, DV_A),
        'qh': qh.reshape(b, l, N_HEADS_B, DK_B).astype(jnp.float32),
        'gf': gf, 'gb': gb,
        'kf': -jnp.expm1(gf), 'kb': -jnp.expm1(gb),
        'vh': ih.reshape(b, l, N_HEADS_B, DV_B).astype(jnp.float32),
        'og': gh.reshape(b, l, N_HEADS_B, DV_B),
        'uf': uf,
    }


def merge(att, rec, four, w_out, dt):
    return jnp.concatenate([att.astype(dt), rec.astype(dt), four.astype(dt)], axis=-1) @ w_out


def setup_inputs(seed: int = 0) -> dict:
    key = jax.random.key(seed)
    ks = jax.random.split(key, 20)
    f32 = jnp.float32

    def nrm(k, shape, s):
        return s * jax.random.normal(k, shape, f32)

    return {
        'x': nrm(ks[0], (BATCH, SEQ, D_MODEL), 1.0),
        'c': nrm(ks[1], (BATCH, D_MODEL), 1.0),
        'ctx': nrm(ks[2], (BATCH, CTX_LEN, D_MODEL), 1.0),
        'c_ctx': nrm(ks[3], (D_MODEL,), 1.0),
        'w_ada': nrm(ks[4], (DEPTH, D_MODEL, 6 * D_MODEL), 0.5 * D_MODEL ** -0.5),
        'b_ada': nrm(ks[5], (DEPTH, 6 * D_MODEL), 0.02),
        'norm1_w': 1.0 + nrm(ks[6], (DEPTH, D_MODEL), 0.05),
        'norm2_w': 1.0 + nrm(ks[7], (DEPTH, D_MODEL), 0.05),
        'w_in': nrm(ks[8], (DEPTH, D_MODEL, PROJ_WIDTH), D_MODEL ** -0.5),
        'lam_qk': nrm(ks[9], (DEPTH, 4, DH_A), 0.1),
        'subln_w': 1.0 + nrm(ks[10], (DEPTH, DV_A), 0.05),
        'lb_param': nrm(ks[11], (DEPTH, 2, WIDTH_BK), 0.5),
        'hgrn_norm_w': 1.0 + nrm(ks[12], (DEPTH, DV_B), 0.05),
        'w_fnet': nrm(ks[13], (DEPTH, WIDTH_C, WIDTH_C), WIDTH_C ** -0.5),
        'w_out': nrm(ks[14], (DEPTH, MIX_WIDTH, D_MODEL), MIX_WIDTH ** -0.5),
        'w_up': nrm(ks[15], (DEPTH, D_MODEL, 2 * D_FF), D_MODEL ** -0.5),
        'conv_w': jnp.array([0.0, 1.0, 0.0], f32)[None, :, None] + nrm(ks[16], (DEPTH, CONV_W, 2 * D_FF), 0.2),
        'conv_b': nrm(ks[17], (DEPTH, 2 * D_FF), 0.02),
        'w_down': nrm(ks[18], (DEPTH, D_FF, D_MODEL), D_FF ** -0.5),
        'final_norm_w': 1.0 + nrm(ks[19], (D_MODEL,), 0.05),
    }


def reference(x, c, ctx, c_ctx, w_ada, b_ada, norm1_w, norm2_w, w_in, lam_qk, subln_w,
              lb_param, hgrn_norm_w, w_fnet, w_out, w_up, conv_w, conv_b, w_down, final_norm_w):
    b, l, _ = x.shape
    rows = l // GRID_W
    cos, sin = axial_rope(rows)
    lb_all = jnp.cumsum(jax.nn.softmax(lb_param.astype(jnp.float32), axis=0), axis=0)
    lb_all = lb_all - lb_all[0:1]
    c_act = jax.nn.silu(c)
    cc_act = jax.nn.silu(c_ctx)
    xc = ctx
    for li in range(DEPTH):
        last = li == DEPTH - 1
        dt = x.dtype
        mod = c_act @ w_ada[li] + b_ada[li]
        sh1, sc1, g1, sh2, sc2, g2 = jnp.split(mod[:, None, :], 6, axis=-1)
        mod_c = cc_act @ w_ada[li] + b_ada[li]
        sh1c, sc1c, g1c, sh2c, sc2c, g2c = jnp.split(mod_c[None, None, :], 6, axis=-1)
        lam_init = 0.8 - 0.6 * math.exp(-0.3 * li)
        lq1, lk1, lq2, lk2 = lam_qk[li].astype(jnp.float32)
        lam = jnp.exp(jnp.sum(lq1 * lk1)) - jnp.exp(jnp.sum(lq2 * lk2)) + lam_init

        m = unpack(modulate(rms_norm(x, norm1_w[li]), sh1, sc1) @ w_in[li], lb_all[li])
        mc = unpack(modulate(rms_norm(xc, norm1_w[li]), sh1c, sc1c) @ w_in[li], lb_all[li])

        k_all = jnp.concatenate([mc['ka'], apply_axial_rope(m['ka'], cos, sin)], axis=1)
        v_all = jnp.concatenate([mc['va'], m['va']], axis=1)
        att = diff_head_norm(diff_attend_blocks(apply_axial_rope(m['qa'], cos, sin), k_all, v_all, lam),
                             subln_w[li], lam_init)

        if last:
            s_f = hgrn_final_state(mc['kf'], mc['vh'], mc['gf'])
            s_b = hgrn_final_state(flip(mc['kb']), flip(mc['vh']), flip(mc['gb']))
        else:
            zeros = jnp.zeros((xc.shape[0], N_HEADS_B, DK_B, DV_B), jnp.float32)
            o_c, s_f, s_b = hgrn_bidir(mc, zeros, zeros)
        o_l, _, _ = hgrn_bidir(m, s_f, s_b)
        rec = hgrn_out(o_l, m['og'], hgrn_norm_w[li])

        four = fourier_mix(m['uf'], w_fnet[li])

        x = x + g1 * merge(att, rec, four, w_out[li], dt)
        x = x + g2 * conv_ffn(modulate(rms_norm(x, norm2_w[li]), sh2, sc2),
                              w_up[li], conv_w[li], conv_b[li], w_down[li])

        if not last:
            att_c = diff_head_norm(diff_attend(mc['qa'], mc['ka'], mc['va'], lam), subln_w[li], lam_init)
            rec_c = hgrn_out(o_c, mc['og'], hgrn_norm_w[li])
            four_c = fourier_mix(mc['uf'], w_fnet[li])
            xc = xc + g1c * merge(att_c, rec_c, four_c, w_out[li], dt)
            xc = xc + g2c * conv_ffn(modulate(rms_norm(xc, norm2_w[li]), sh2c, sc2c),
                                     w_up[li], conv_w[li], conv_b[li], w_down[li])
    return rms_norm(x, final_norm_w)
```

```cpp
#include <hip/hip_runtime.h>
#include <hip/hip_cooperative_groups.h>
#include <cstdio>
#include <cstdint>
namespace pg8 {
#define PG8_LAS __attribute__((address_space(3)))
typedef unsigned short bf16_t;
typedef short bf16x8 __attribute__((ext_vector_type(8)));
typedef float f32x4 __attribute__((ext_vector_type(4)));
typedef unsigned u32x4 __attribute__((ext_vector_type(4)));
constexpr int BM = 256, BK = 64, HALF = 128, HTB = HALF * BK * 2  , STAGE_BYTES = 8 * HTB, NXCD = 8, WGM = 8;

__host__ __device__ __forceinline__ int lds_byte(int r, int c) { const int st = (r >> 4) * 2 + (c >> 5), rr = r & 15, cc = c & 31, ob = rr * 64 + cc * 2; return st * 1024 + (ob ^ (((ob >> 9) & 1) << 5)); }
__host__ __device__ __forceinline__ void stage_rc(int b, int& R, int& C) { const int st = b / 1024, sb = b % 1024, swz = sb ^ (((sb >> 9) & 1) << 5); R = (st >> 1) * 16 + swz / 64; C = (st & 1) * 32 + (swz % 64) / 2; }
__host__ __device__ __forceinline__ int perm32(int rho) { const int n = rho >> 4, i = rho & 15; return 8 * (i >> 2) + 4 * n + (i & 3); }

struct Unit { int pm, pn; };
struct Gemm { const bf16_t* A; const bf16_t* Bt; int M, N, K, pad; };

struct StaticOrder {
    int nM, nN, nwg, G, c;
    __host__ __device__ void init(int M, int N, int G_, int c_) { nM = M / BM; nN = N / BM; nwg = nM * nN; G = G_; c = c_; }
    __host__ __device__ bool next(int i, Unit& u) const {
        const long L = (long)i * G + c; if (L >= nwg) return false;
        int wgid = (int)L; { const int q = nwg / NXCD, r = nwg % NXCD, xcd = wgid % NXCD, off = wgid / NXCD; wgid = (xcd < r ? xcd * (q + 1) : r * (q + 1) + (xcd - r) * q) + off; }
        const int nig = WGM * nN, gid = wgid / nig, fm = gid * WGM, gsz = (nM - fm) < WGM ? (nM - fm) : WGM;
        u.pm = fm + ((wgid % nig) % gsz); u.pn = (wgid % nig) / gsz; return true;
    }
    __device__ __forceinline__ void a_ready(const Unit&) const {}
    __device__ __forceinline__ void done(const Unit&) const {}
};

template <class Epi, class Sched, bool ALIGN_EPI = false, bool SP2 = false>
__device__ __forceinline__ void gemm_phase(PG8_LAS unsigned char* lds, const Gemm g, const Sched& S, const Epi& E) {
    const int tid = threadIdx.x, wid = __builtin_amdgcn_readfirstlane(tid >> 6), lane = tid & 63, wr = wid >> 2, wc = wid & 3, fr = lane & 15, fq = lane >> 4;
    const int K = g.K, nt = K / BK;
    unsigned voffA[2], voffB[2];
#pragma unroll
    for (int i = 0; i < 2; ++i) { int R, C; stage_rc(tid * 16 + i * 8192, R, C); const int Rb = Epi::PERM ? ((R & ~31) + perm32(R & 31)) : R;
        voffA[i] = (unsigned)(R * K + C) * 2u; voffB[i] = (unsigned)(Rb * K + C) * 2u; }
    const size_t kstep = (size_t)(BK * 2);
    const size_t hstep = (size_t)HALF * K * 2;
    const size_t tstep = 2 * hstep;
    const unsigned ldsw = (unsigned)wid * 1024u;
    const int aoff = lds_byte(wr * 64 + fr, fq * 8), boff = lds_byte(wc * 32 + fr, fq * 8);
#define PG8_SA(b, h) (((b) * 2 + (h)) * HTB)
#define PG8_SB(b, h) ((4 + (b) * 2 + (h)) * HTB)
#define PG8_STAGE(bufoff, gbase, voff) do { _Pragma("unroll") for (int _i = 0; _i < 2; ++_i) \
        __builtin_amdgcn_global_load_lds((const unsigned*)((const char*)(gbase) + (voff)[_i]), (PG8_LAS unsigned*)(lds + (bufoff) + ldsw + _i * 8192), 16, 0, 0); } while (0)
#define PG8_LDA(dst, b, h) do { _Pragma("unroll") for (int m = 0; m < 4; ++m) _Pragma("unroll") for (int k = 0; k < 2; ++k) dst[m][k] = *(const PG8_LAS bf16x8*)(lds + PG8_SA(b, h) + aoff + m * 2048 + k * 1024); } while (0)
#define PG8_LDB(dst, b, h) do { _Pragma("unroll") for (int n = 0; n < 2; ++n) _Pragma("unroll") for (int k = 0; k < 2; ++k) dst[n][k] = *(const PG8_LAS bf16x8*)(lds + PG8_SB(b, h) + boff + n * 2048 + k * 1024); } while (0)
#define PG8_MMA(ai, bj, At, Bt) do { __builtin_amdgcn_s_setprio(1); _Pragma("unroll") for (int m = 0; m < 4; ++m) _Pragma("unroll") for (int n = 0; n < 2; ++n) _Pragma("unroll") for (int k = 0; k < 2; ++k) \
        acc[ai][bj][m][n] = __builtin_amdgcn_mfma_f32_16x16x32_bf16(Bt[n][k], At[m][k], acc[ai][bj][m][n], 0, 0, 0); __builtin_amdgcn_s_setprio(0); } while (0)
#define PG8_WAIT_V(n) asm volatile("s_waitcnt vmcnt(" #n ")" ::: "memory")
#define PG8_WAIT_L(n) asm volatile("s_waitcnt lgkmcnt(" #n ")" ::: "memory")
#define PG8_BAR __builtin_amdgcn_s_barrier()
#define PG8_SCHED __builtin_amdgcn_sched_barrier(0)
    Unit cur, nxt; int ui = 0;
    if (!S.next(0, cur)) return;
    f32x4 acc[2][2][4][2];
#pragma unroll
    for (int a = 0; a < 2; ++a)
#pragma unroll
        for (int b = 0; b < 2; ++b)
#pragma unroll
            for (int m = 0; m < 4; ++m)
#pragma unroll
                for (int n = 0; n < 2; ++n) acc[a][b][m][n] = (f32x4){0.f, 0.f, 0.f, 0.f};
    bf16x8 At[4][2], B0[2][2], B1[2][2];
    const char* cA = (const char*)g.A + (size_t)cur.pm * tstep; const char* cB = (const char*)g.Bt + (size_t)cur.pn * tstep;
    S.a_ready(cur);
    if constexpr (SP2) {
        PG8_STAGE(PG8_SB(0, 0), cB, voffB); PG8_STAGE(PG8_SB(0, 1), cB + hstep, voffB); PG8_STAGE(PG8_SA(0, 0), cA, voffA); PG8_STAGE(PG8_SA(0, 1), cA + hstep, voffA);
        if (wr == 1) PG8_BAR;
        PG8_WAIT_V(2); PG8_BAR;
        PG8_STAGE(PG8_SB(1, 0), cB + kstep, voffB); PG8_STAGE(PG8_SA(1, 0), cA + kstep, voffA); PG8_STAGE(PG8_SB(1, 1), cB + hstep + kstep, voffB);
        PG8_WAIT_V(6); PG8_BAR;
    } else {
        PG8_STAGE(PG8_SB(0, 0), cB, voffB); PG8_STAGE(PG8_SA(0, 0), cA, voffA); PG8_STAGE(PG8_SB(0, 1), cB + hstep, voffB); PG8_STAGE(PG8_SA(0, 1), cA + hstep, voffA);
        if (wr == 1) PG8_BAR;
        PG8_WAIT_V(4); PG8_BAR;
        PG8_STAGE(PG8_SB(1, 0), cB + kstep, voffB); PG8_STAGE(PG8_SA(1, 0), cA + kstep, voffA); PG8_STAGE(PG8_SB(1, 1), cB + hstep + kstep, voffB);
        PG8_WAIT_V(6); PG8_BAR;
    }
    for (;;) {
        const bool has_next = S.next(ui + 1, nxt);
        const char* nA = has_next ? (const char*)g.A + (size_t)nxt.pm * tstep : cA; const char* nB = has_next ? (const char*)g.Bt + (size_t)nxt.pn * tstep : cB;
        for (int t = 0; t < nt; t += 2) {
            const bool last = (t == nt - 2);
            const char* a1 = cA + (size_t)(t + 1) * kstep;
            const char* a2 = last ? nA : cA + (size_t)(t + 2) * kstep; const char* b2 = last ? nB : cB + (size_t)(t + 2) * kstep;
            const char* a3 = a2 + kstep; const char* b3 = b2 + kstep;
            if (last && has_next) S.a_ready(nxt);
            if constexpr (SP2) {
            PG8_LDB(B0, 0, 0); PG8_LDB(B1, 0, 1); PG8_SCHED; PG8_LDA(At, 0, 0); PG8_STAGE(PG8_SA(1, 1), a1 + hstep, voffA);
            PG8_WAIT_V(8); PG8_WAIT_L(0); PG8_BAR; PG8_MMA(0, 0, At, B0); PG8_MMA(0, 1, At, B1); PG8_BAR; PG8_SCHED;
            PG8_LDA(At, 0, 1); PG8_STAGE(PG8_SB(0, 0), b2, voffB); PG8_STAGE(PG8_SB(0, 1), b2 + hstep, voffB); PG8_STAGE(PG8_SA(0, 0), a2, voffA);
            PG8_WAIT_V(8); PG8_WAIT_L(0); PG8_BAR; PG8_MMA(1, 0, At, B0); PG8_MMA(1, 1, At, B1); PG8_BAR; PG8_SCHED;
            PG8_LDB(B0, 1, 0); PG8_LDB(B1, 1, 1); PG8_SCHED; PG8_LDA(At, 1, 0); PG8_STAGE(PG8_SA(0, 1), a2 + hstep, voffA);
            PG8_WAIT_V(8); PG8_WAIT_L(0); PG8_BAR; PG8_MMA(0, 0, At, B0); PG8_MMA(0, 1, At, B1); PG8_BAR; PG8_SCHED;
            PG8_LDA(At, 1, 1); PG8_STAGE(PG8_SB(1, 0), b3, voffB); PG8_STAGE(PG8_SB(1, 1), b3 + hstep, voffB); PG8_STAGE(PG8_SA(1, 0), a3, voffA);
            PG8_WAIT_V(8); PG8_WAIT_L(0); PG8_BAR; PG8_MMA(1, 0, At, B0); PG8_MMA(1, 1, At, B1); PG8_BAR; PG8_SCHED;
            } else {
            PG8_LDB(B0, 0, 0); PG8_SCHED; PG8_LDA(At, 0, 0); PG8_STAGE(PG8_SA(1, 1), a1 + hstep, voffA);
            PG8_WAIT_L(8); PG8_BAR; PG8_WAIT_L(0); PG8_MMA(0, 0, At, B0); PG8_BAR; PG8_SCHED;
            PG8_LDB(B1, 0, 1); PG8_STAGE(PG8_SB(0, 0), b2, voffB);
            PG8_BAR; PG8_WAIT_L(0); PG8_MMA(0, 1, At, B1); PG8_BAR;
            PG8_LDA(At, 0, 1); PG8_STAGE(PG8_SA(0, 0), a2, voffA);
            PG8_BAR; PG8_WAIT_L(0); PG8_MMA(1, 0, At, B0); PG8_BAR; PG8_SCHED;
            PG8_STAGE(PG8_SB(0, 1), b2 + hstep, voffB);
            PG8_WAIT_V(6); PG8_BAR; PG8_MMA(1, 1, At, B1); PG8_BAR;
            PG8_LDB(B0, 1, 0); PG8_SCHED; PG8_LDA(At, 1, 0); PG8_STAGE(PG8_SA(0, 1), a2 + hstep, voffA);
            PG8_WAIT_L(8); PG8_BAR; PG8_WAIT_L(0); PG8_MMA(0, 0, At, B0); PG8_BAR; PG8_SCHED;
            PG8_LDB(B1, 1, 1); PG8_STAGE(PG8_SB(1, 0), b3, voffB);
            PG8_BAR; PG8_WAIT_L(0); PG8_MMA(0, 1, At, B1); PG8_BAR;
            PG8_LDA(At, 1, 1); PG8_STAGE(PG8_SA(1, 0), a3, voffA);
            PG8_BAR; PG8_WAIT_L(0); PG8_MMA(1, 0, At, B0); PG8_BAR; PG8_SCHED;
            PG8_STAGE(PG8_SB(1, 1), b3 + hstep, voffB);
            PG8_WAIT_V(6); PG8_BAR; PG8_MMA(1, 1, At, B1); PG8_BAR;
            }
        }
        if constexpr (ALIGN_EPI) { if (wr == 0) PG8_BAR; }
        if constexpr (!Epi::AFTER_DRAIN) { E(acc, cur, wr, wc, fr, fq); S.done(cur); }
        if (!has_next) break;
#pragma unroll
        for (int a = 0; a < 2; ++a)
#pragma unroll
            for (int b = 0; b < 2; ++b)
#pragma unroll
                for (int m = 0; m < 4; ++m)
#pragma unroll
                    for (int n = 0; n < 2; ++n) acc[a][b][m][n] = (f32x4){0.f, 0.f, 0.f, 0.f};
        cur = nxt; cA = nA; cB = nB; ++ui;
        if constexpr (ALIGN_EPI) { if (wr == 1) PG8_BAR; }
    }
    PG8_WAIT_V(0);
    if constexpr (!ALIGN_EPI) { if (wr == 0) PG8_BAR; }
    PG8_BAR;
    if constexpr (Epi::AFTER_DRAIN) { E.fused(acc, cur, wr, wc, fr, fq, lds, wid, lane); S.done(cur); }
#undef PG8_SA
#undef PG8_SB
#undef PG8_STAGE
#undef PG8_LDA
#undef PG8_LDB
#undef PG8_MMA
#undef PG8_WAIT_V
#undef PG8_WAIT_L
#undef PG8_BAR
#undef PG8_SCHED
}
}

using pg8::bf16_t; using pg8::bf16x8; using pg8::f32x4;
typedef float f32x16 __attribute__((ext_vector_type(16)));
typedef short s16x4 __attribute__((ext_vector_type(4)));
typedef unsigned u32x4 __attribute__((ext_vector_type(4)));
typedef unsigned u32x2 __attribute__((ext_vector_type(2)));
#define LAS __attribute__((address_space(3)))

constexpr int DM = 1024, NB = 8, SEQ = 2048, CTX = 256, MLAT = NB * SEQ, MCTX = NB * CTX, MTOT = MLAT + MCTX;
constexpr int PW = 3072, DFF = 2816, KEYS = SEQ + CTX, NCH = 36  ;
constexpr float EPS = 1e-6f;
constexpr float QSCALE = 0.125f * 1.4426950408889634f;

constexpr size_t MiB = 1u << 20;
constexpr size_t WS_CTL = 0;
constexpr size_t WS_MOD = 64 * 1024;
constexpr size_t WS_LAM = 512 * 1024;
constexpr size_t WS_LB = WS_LAM + 256;
constexpr size_t WS_ROPE = WS_LB + 4096;
constexpr size_t WS_STATS = 1 * MiB;
constexpr size_t WS_WIN = 4 * MiB;
constexpr size_t WS_WOUT = 16 * MiB;
constexpr size_t WS_WUP = 21 * MiB;
constexpr size_t WS_WDOWN = 32 * MiB;
constexpr size_t WS_DFT = 38 * MiB;
constexpr size_t WS_DFTC = 46 * MiB;
constexpr size_t WS_CTXX = 47 * MiB;
constexpr size_t WS_H = 55 * MiB;
constexpr size_t WS_QA = 91 * MiB;
constexpr size_t WS_KC = 109 * MiB;
constexpr size_t WS_VT = 127 * MiB;
constexpr size_t WS_QH = 145 * MiB;
constexpr size_t WS_VH = 154 * MiB;
constexpr size_t WS_OG = 163 * MiB;
constexpr size_t WS_UU = 172 * MiB;
constexpr size_t WS_GF = 181 * MiB;
constexpr size_t WS_GB = 199 * MiB;
constexpr size_t WS_L = 217 * MiB;
constexpr size_t WS_DC = 235 * MiB;
constexpr size_t WS_BT = 236 * MiB;
constexpr size_t WS_BTC = 244 * MiB;
constexpr size_t WS_FOLD = 245 * MiB;
constexpr size_t WS_G = 91 * MiB;
constexpr size_t WS_UCH = 190 * MiB;
constexpr size_t WS_END = 248 * MiB;

__device__ __forceinline__ bf16_t f2bf(float f) { unsigned u = __float_as_uint(f); return (bf16_t)((u + 0x7fffu + ((u >> 16) & 1u)) >> 16); }
__device__ __forceinline__ float bf2f(bf16_t h) { return __uint_as_float(((unsigned)h) << 16); }
__device__ __forceinline__ unsigned pk2(float lo, float hi) { return (unsigned)f2bf(lo) | ((unsigned)f2bf(hi) << 16); }
__device__ __forceinline__ float silu_f(float v) { return v / (1.f + __expf(-v)); }
__device__ __forceinline__ float wave_sum(float v) {
#pragma unroll
    for (int o = 1; o < 64; o <<= 1) v += __shfl_xor(v, o);
    return v;
}

__global__ void k_small(const float* lam_qk, const float* lb_param, float* lam_out, float* lb_out, float* rope) {
    const int tid = threadIdx.x;
    if (tid < 2) {
        const float* p = lam_qk + tid * 256; float s1 = 0.f, s2 = 0.f;
        for (int i = 0; i < 64; ++i) { s1 += p[i] * p[64 + i]; s2 += p[128 + i] * p[192 + i]; }
        const float lam_init = 0.8f - 0.6f * expf(-0.3f * (float)tid);
        lam_out[tid] = expf(s1) - expf(s2) + lam_init; lam_out[2 + tid] = 1.f - lam_init;
    }
    for (int i = tid; i < 512; i += blockDim.x) {
        const float p0 = lb_param[i], p1 = lb_param[512 + i];
        lb_out[i] = 0.f; lb_out[512 + i] = 1.f / (1.f + expf(p0 - p1));
    }
    for (int i = tid; i < 1024; i += blockDim.x) {
        const int pos = i >> 4, j = i & 15;
        const double f = pow(10000.0, -(double)j / 16.0), a = (double)pos * f;
        rope[i] = (float)cos(a); rope[1024 + i] = (float)sin(a);
    }
}
__global__ void __launch_bounds__(512) k_adaln(const float* c, const float* cctx, const float* w_ada, const float* b_ada, float* mod) {
    __shared__ float cs[9][1024]; __shared__ float red[8][9][64];
    const int tid = threadIdx.x, li = blockIdx.x / 96, nb = blockIdx.x % 96, n = nb * 64 + (tid & 63), ks = tid >> 6;
    for (int i = tid; i < 9 * 1024; i += 512) { const int r = i >> 10, k = i & 1023; const float v = r < 8 ? c[r * 1024 + k] : cctx[k]; cs[r][k] = silu_f(v); }
    __syncthreads();
    float acc[9];
#pragma unroll
    for (int r = 0; r < 9; ++r) acc[r] = 0.f;
    const float* W = w_ada + (size_t)li * 1024 * 6144 + n;
    for (int k = ks * 128; k < ks * 128 + 128; ++k) { const float w = W[(size_t)k * 6144];
#pragma unroll
        for (int r = 0; r < 9; ++r) acc[r] += cs[r][k] * w; }
#pragma unroll
    for (int r = 0; r < 9; ++r) red[ks][r][tid & 63] = acc[r];
    __syncthreads();
    for (int i = tid; i < 9 * 64; i += 512) { const int r = i >> 6, nn = i & 63; float s = b_ada[li * 6144 + nb * 64 + nn];
        for (int q = 0; q < 8; ++q) s += red[q][r][nn];
        mod[((size_t)li * 9 + r) * 6144 + nb * 64 + nn] = s; }
}
__global__ void __launch_bounds__(256) k_fold(const float* w_fnet, const float* w_out, float* F) {
    const int li = blockIdx.z, i = blockIdx.y, n = blockIdx.x * 256 + threadIdx.x;
    __shared__ float wf[256];
    wf[threadIdx.x] = w_fnet[((size_t)li * 256 + i) * 256 + threadIdx.x];
    __syncthreads();
    const float* wo = w_out + ((size_t)li * 1024 + 768) * 1024 + n; float s = 0.f;
    for (int j = 0; j < 256; ++j) s += wf[j] * wo[(size_t)j * 1024];
    F[((size_t)li * 256 + i) * 1024 + n] = s;
}
__global__ void __launch_bounds__(256) k_transpose(const float* W, const float* W2, bf16_t* WT, int ksplit, int K, int N, int upperm) {
    __shared__ float t[32][33];
    const int n0 = blockIdx.x * 32, k0 = blockIdx.y * 32, tx = threadIdx.x & 31, ty = threadIdx.x >> 5;
    for (int i = ty; i < 32; i += 8) {
        const int np = n0 + tx; int col = np;
        if (upperm) { const int tile = np >> 8, w = np & 255; col = w < 128 ? tile * 128 + w : DFF + tile * 128 + (w - 128); }
        const int k = k0 + i;
        t[i][tx] = (k < ksplit) ? W[(size_t)k * N + col] : W2[(size_t)(k - ksplit) * N + col];
    }
    __syncthreads();
    for (int i = ty; i < 32; i += 8) WT[(size_t)(n0 + i) * K + k0 + tx] = f2bf(t[tx][i]);
}
__global__ void k_dftgen(bf16_t* A, int L) {
    const int idx = blockIdx.x * blockDim.x + threadIdx.x; if (idx >= L * L) return;
    const int lp = idx / L, kk = idx % L, h = L / 2; const int k = kk <= h ? kk : kk - h;
    const int ph = (int)(((long)k * lp) % L);
    float s, c; sincospif(2.0f * (float)ph / (float)L, &s, &c);
    const float sc = rsqrtf((float)L);
    A[idx] = f2bf(kk <= h ? c * sc : -s * sc);
}
__global__ void __launch_bounds__(512) k_normmod(const float* xlat, const float* xctx, const float* w, const float* mod, bf16_t* H, int shoff, int nrows) {
    const int lane = threadIdx.x & 63, row = blockIdx.x * 8 + (threadIdx.x >> 6); if (row >= nrows) return;
    const float* src = row < MLAT ? xlat + (size_t)row * DM : xctx + (size_t)(row - MLAT) * DM;
    const float* mv = mod + (size_t)(row < MLAT ? (row >> 11) : 8) * 6144 + shoff;
    f32x4 v[4]; float ss = 0.f;
#pragma unroll
    for (int j = 0; j < 4; ++j) { v[j] = *(const f32x4*)(src + (lane + 64 * j) * 4); ss += v[j][0] * v[j][0] + v[j][1] * v[j][1] + v[j][2] * v[j][2] + v[j][3] * v[j][3]; }
    const float rstd = rsqrtf(wave_sum(ss) * (1.f / DM) + EPS);
#pragma unroll
    for (int j = 0; j < 4; ++j) { const int c = (lane + 64 * j) * 4;
        const f32x4 wv = *(const f32x4*)(w + c), sh = *(const f32x4*)(mv + c), sc = *(const f32x4*)(mv + 1024 + c);
        float o[4];
#pragma unroll
        for (int e = 0; e < 4; ++e) o[e] = (v[j][e] * rstd * wv[e]) * (1.f + sc[e]) + sh[e];
        u32x2 pk; pk.x = pk2(o[0], o[1]); pk.y = pk2(o[2], o[3]);
        *(u32x2*)(H + (size_t)row * DM + c) = pk; }
}
__global__ void __launch_bounds__(512) k_finalnorm(float* x, const float* w, int nrows) {
    const int lane = threadIdx.x & 63, row = blockIdx.x * 8 + (threadIdx.x >> 6); if (row >= nrows) return;
    float* src = x + (size_t)row * DM;
    f32x4 v[4]; float ss = 0.f;
#pragma unroll
    for (int j = 0; j < 4; ++j) { v[j] = *(const f32x4*)(src + (lane + 64 * j) * 4); ss += v[j][0] * v[j][0] + v[j][1] * v[j][1] + v[j][2] * v[j][2] + v[j][3] * v[j][3]; }
    const float rstd = rsqrtf(wave_sum(ss) * (1.f / DM) + EPS);
#pragma unroll
    for (int j = 0; j < 4; ++j) { const int c = (lane + 64 * j) * 4; const f32x4 wv = *(const f32x4*)(w + c);
        f32x4 o; for (int e = 0; e < 4; ++e) o[e] = v[j][e] * rstd * wv[e];
        *(f32x4*)(src + c) = o; }
}

template <class F> __device__ __forceinline__ void epi_for_each(const f32x4 (&acc)[2][2][4][2], const pg8::Unit& u, int wr, int wc, int fr, int fq, F f) {
#pragma unroll
    for (int ai = 0; ai < 2; ++ai)
#pragma unroll
        for (int m = 0; m < 4; ++m) { const int row = u.pm * 256 + ai * 128 + wr * 64 + m * 16 + fr;
#pragma unroll
            for (int bj = 0; bj < 2; ++bj) { const int col = u.pn * 256 + bj * 128 + wc * 32 + fq * 8;
                float v[8];
#pragma unroll
                for (int e = 0; e < 4; ++e) { v[e] = acc[ai][bj][m][0][e]; v[4 + e] = acc[ai][bj][m][1][e]; }
                f(row, col, v); } }
}
__device__ __forceinline__ void store8_bf16(bf16_t* p, const float* v) { u32x4 w; w.x = pk2(v[0], v[1]); w.y = pk2(v[2], v[3]); w.z = pk2(v[4], v[5]); w.w = pk2(v[6], v[7]); *(u32x4*)p = w; }

struct EpiStoreBf16 {
    static constexpr bool PERM = true, AFTER_DRAIN = false;
    bf16_t* O; int ldc, pad;
    __device__ __forceinline__ void operator()(const f32x4 (&acc)[2][2][4][2], const pg8::Unit& u, int wr, int wc, int fr, int fq) const {
        epi_for_each(acc, u, wr, wc, fr, fq, [&](int row, int col, float* v) __attribute__((always_inline)) { store8_bf16(O + (size_t)row * ldc + col, v); });
    }
};
struct EpiDft {
    static constexpr bool PERM = true, AFTER_DRAIN = false;
    bf16_t* MIX; int rowbase, L;
    __device__ __forceinline__ void operator()(const f32x4 (&acc)[2][2][4][2], const pg8::Unit& u, int wr, int wc, int fr, int fq) const {
        epi_for_each(acc, u, wr, wc, fr, fq, [&](int row, int col, float* v) __attribute__((always_inline)) { const int b = col >> 8, ch = col & 255; store8_bf16(MIX + (size_t)(rowbase + b * L + row) * DM + 768 + ch, v); });
    }
};
struct EpiResid {
    static constexpr bool PERM = true, AFTER_DRAIN = false;
    const float* xin_lat; const float* xin_ctx; float* xout_lat; float* xout_ctx; const float* mod; int goff, pad;
    __device__ __forceinline__ void operator()(const f32x4 (&acc)[2][2][4][2], const pg8::Unit& u, int wr, int wc, int fr, int fq) const {
        const bool ctx = u.pm >= 64; const float* gv = mod + (size_t)(ctx ? 8 : (u.pm >> 3)) * 6144 + goff;
        const float* xi = ctx ? xin_ctx - (size_t)MLAT * DM : xin_lat; float* xo = ctx ? xout_ctx - (size_t)MLAT * DM : xout_lat;
        epi_for_each(acc, u, wr, wc, fr, fq, [&](int row, int col, float* v) __attribute__((always_inline)) {
            const size_t off = (size_t)row * DM + col; const f32x4 g0 = *(const f32x4*)(gv + col), g1 = *(const f32x4*)(gv + col + 4);
            const f32x4 x0 = *(const f32x4*)(xi + off), x1 = *(const f32x4*)(xi + off + 4); f32x4 o0, o1;
            for (int e = 0; e < 4; ++e) { o0[e] = x0[e] + g0[e] * v[e]; o1[e] = x1[e] + g1[e] * v[4 + e]; }
            *(f32x4*)(xo + off) = o0; *(f32x4*)(xo + off + 4) = o1; });
    }
};
__device__ __forceinline__ float log_forget(float z, float lb) {
    const float e = __expf(-fabsf(z)), r = __builtin_amdgcn_rcpf(1.f + e);
    if (lb <= 0.f) { const float l1p = e < 0.01f ? e * (1.f - e * (0.5f - e * 0.33333333f)) : __logf(1.f + e); return fminf(z, 0.f) - l1p; }
    const float k = (1.f - lb) * (z >= 0.f ? e * r : r);
    return k < 0.01f ? -k * (1.f + k * (0.5f + k * 0.33333333f)) : __logf(1.f - k);
}
struct EpiInProj {
    static constexpr bool PERM = true, AFTER_DRAIN = false;
    bf16_t *QA, *KC, *VT, *QH, *VH, *OG, *UU; float *GF, *GB; const float* rope; const float* lb;
    __device__ __forceinline__ void operator()(const f32x4 (&acc)[2][2][4][2], const pg8::Unit& u, int wr, int wc, int fr, int fq) const {
        const int pn = u.pn; const bool ctx = u.pm >= 64;
        if (pn < 4) {
            epi_for_each(acc, u, wr, wc, fr, fq, [&](int row, int col, float* v) __attribute__((always_inline)) {
                int b, t; if (ctx) { const int rc = row - MLAT; b = rc >> 8; t = rc & 255; } else { b = row >> 11; t = row & 2047; }
                if (!ctx) {
                    const int cl = col & 63, gi = cl >> 5, i0 = cl & 31, j0 = i0 & 15; const bool second = i0 >= 16;
                    const int pos = gi ? (t & 63) : (t >> 6);
                    const float* ct = rope + pos * 16 + j0; const f32x4 c0 = *(const f32x4*)ct, c1 = *(const f32x4*)(ct + 4), s0 = *(const f32x4*)(ct + 1024), s1 = *(const f32x4*)(ct + 1028);
#pragma unroll
                    for (int e = 0; e < 8; ++e) { const float pr = __shfl_xor(v[e], 32); const float cs = e < 4 ? c0[e & 3] : c1[e & 3], sn = e < 4 ? s0[e & 3] : s1[e & 3]; v[e] = second ? v[e] * cs + pr * sn : v[e] * cs - pr * sn; }
                }
                if (pn < 2) {
#pragma unroll
                    for (int e = 0; e < 8; ++e) v[e] *= QSCALE;
                    store8_bf16(QA + (size_t)row * 512 + col, v);
                } else store8_bf16(KC + (size_t)(b * KEYS + (ctx ? t : CTX + t)) * 512 + (col - 512), v);
                asm volatile("" ::: "memory"); });
        } else if (pn < 6) {
            epi_for_each(acc, u, wr, wc, fr, fq, [&](int row, int col, float* v) __attribute__((always_inline)) {
                int b, t; if (ctx) { const int rc = row - MLAT; b = rc >> 8; t = rc & 255; } else { b = row >> 11; t = row & 2047; }
                const int cc = col - 1024, hh = cc >> 7, dv = cc & 127, key = ctx ? t : CTX + t;
                bf16_t* p = VT + ((size_t)((b * 4 + hh) * 128 + dv)) * KEYS + key;
#pragma unroll
                for (int e = 0; e < 8; ++e) p[(size_t)e * KEYS] = f2bf(v[e]);
                asm volatile("" ::: "memory"); });
        } else if (pn == 7 || pn == 8) {
            const float* lbp0 = lb + (pn == 7 ? 0 : 256) - (pn == 7 ? 1792 : 2048); float* G0 = (pn == 7 ? GF : GB) - (pn == 7 ? 1792 : 2048);
            epi_for_each(acc, u, wr, wc, fr, fq, [&](int row, int col, float* v) __attribute__((always_inline)) {
                const float* lbp = lbp0 + col; float* G = G0 + (size_t)row * 256 + col;
                (void)lbp; f32x4 o0, o1;
#pragma unroll
                for (int e = 0; e < 4; ++e) { o0[e] = v[e]; o1[e] = v[4 + e]; }
                *(f32x4*)G = o0; *(f32x4*)(G + 4) = o1;
                asm volatile("" ::: "memory"); });
        } else {
            bf16_t* dst = pn == 6 ? QH : pn == 9 ? VH : pn == 10 ? OG : UU; const int c0 = pn * 256; const bool act = pn == 10;
            epi_for_each(acc, u, wr, wc, fr, fq, [&](int row, int col, float* v) __attribute__((always_inline)) {
                if (act) {
#pragma unroll
                    for (int e = 0; e < 8; ++e) v[e] = silu_f(v[e]);
                }
                store8_bf16(dst + (size_t)row * 256 + (col - c0), v);
                asm volatile("" ::: "memory"); });
        }
    }
};

template <class Epi> __global__ void __launch_bounds__(512, 2) k_gemm(pg8::Gemm g, Epi E) {
    extern __shared__ __attribute__((aligned(16))) unsigned char lds[];
    pg8::StaticOrder S; S.init(g.M, g.N, (int)gridDim.x, (int)blockIdx.x);
    pg8::gemm_phase<Epi, pg8::StaticOrder, true, true>((LAS unsigned char*)lds, g, S, E);
}

constexpr int KS_STRIDE = 272, VS_STRIDE = 136;
struct AttnArgs { const bf16_t* QA; const bf16_t* KC; const bf16_t* VT; float* STATS; bf16_t* MIX; const float* lamp; const float* subw; int nlat, nunits; };
template <int PASS> __device__ __forceinline__ void attn_unit(unsigned char* lds, const AttnArgs& A, int unit) {
    const int tid = threadIdx.x, lane = tid & 63, wid = tid >> 6, r32 = lane & 31, hi = lane >> 5;
    int b, h, qrow0, nkeys;
    if (unit < A.nlat) { b = unit >> 5; h = (unit >> 3) & 3; qrow0 = b * SEQ + (unit & 7) * 256; nkeys = KEYS; }
    else { const int uc = unit - A.nlat; b = uc >> 2; h = uc & 3; qrow0 = MLAT + b * CTX; nkeys = CTX; }
    unsigned char* Ks = lds; unsigned char* Vs = lds + 64 * KS_STRIDE;
    const int qrow = qrow0 + wid * 32 + r32;
    bf16x8 qf[2][4];
    { const bf16_t* qp = A.QA + (size_t)qrow * 512 + h * 128 + hi * 8;
#pragma unroll
      for (int c = 0; c < 2; ++c)
#pragma unroll
          for (int s = 0; s < 4; ++s) qf[c][s] = *(const bf16x8*)(qp + c * 64 + s * 16); }
    const float lam = A.lamp[0];
    float m0 = -1e30f, m1 = -1e30f, l0 = 0.f, l1 = 0.f, nM0 = 0.f, nM1 = 0.f;
    f32x16 O[4];
    if (PASS == 2) { nM0 = -A.STATS[(size_t)qrow * 8 + h * 2]; nM1 = -A.STATS[(size_t)qrow * 8 + h * 2 + 1];
#pragma unroll
        for (int d = 0; d < 4; ++d)
#pragma unroll
            for (int r = 0; r < 16; ++r) O[d][r] = 0.f; }
    const bf16_t* kbase = A.KC + (size_t)b * KEYS * 512 + h * 128;
    const bf16_t* vbase = A.VT + (size_t)((b * 4 + h) * 128) * KEYS;
    for (int t0 = 0; t0 < nkeys; t0 += 64) {
        __syncthreads();
#pragma unroll
        for (int i = 0; i < 2; ++i) { const int idx = tid + 512 * i, row = idx >> 4, ch = idx & 15;
            *(u32x4*)(Ks + row * KS_STRIDE + ch * 16) = *(const u32x4*)(kbase + (size_t)(t0 + row) * 512 + ch * 8); }
        if (PASS == 2) {
#pragma unroll
            for (int i = 0; i < 2; ++i) { const int idx = tid + 512 * i, row = idx >> 3, ch = idx & 7;
                const u32x4 w = *(const u32x4*)(vbase + (size_t)row * KEYS + t0 + ch * 8);
                u32x2 a, c2; a.x = w.x; a.y = w.y; c2.x = w.z; c2.y = w.w;
                *(u32x2*)(Vs + row * VS_STRIDE + ch * 16) = a; *(u32x2*)(Vs + row * VS_STRIDE + ch * 16 + 8) = c2; }
        }
        __syncthreads();
#pragma unroll
        for (int kb = 0; kb < 2; ++kb) {
            f32x16 S0, S1;
#pragma unroll
            for (int r = 0; r < 16; ++r) { S0[r] = nM0; S1[r] = nM1; }
            const unsigned char* kp = Ks + (kb * 32 + r32) * KS_STRIDE + hi * 16;
#pragma unroll
            for (int s = 0; s < 4; ++s) {
                const bf16x8 k0 = *(const bf16x8*)(kp + s * 32), k1 = *(const bf16x8*)(kp + 128 + s * 32);
                S0 = __builtin_amdgcn_mfma_f32_32x32x16_bf16(k0, qf[0][s], S0, 0, 0, 0);
                S1 = __builtin_amdgcn_mfma_f32_32x32x16_bf16(k1, qf[1][s], S1, 0, 0, 0);
            }
            if (PASS == 1) {
                float x0 = S0[0], x1 = S1[0];
#pragma unroll
                for (int r = 1; r < 16; ++r) { x0 = fmaxf(x0, S0[r]); x1 = fmaxf(x1, S1[r]); }
                x0 = fmaxf(x0, __shfl_xor(x0, 32)); x1 = fmaxf(x1, __shfl_xor(x1, 32));
                const float n0 = fmaxf(m0, x0), n1 = fmaxf(m1, x1);
                float a0 = 0.f, a1 = 0.f;
#pragma unroll
                for (int r = 0; r < 16; ++r) { a0 += __builtin_amdgcn_exp2f(S0[r] - n0); a1 += __builtin_amdgcn_exp2f(S1[r] - n1); }
                l0 = l0 * __builtin_amdgcn_exp2f(m0 - n0) + a0; l1 = l1 * __builtin_amdgcn_exp2f(m1 - n1) + a1; m0 = n0; m1 = n1;
            } else {
                bf16x8 pa[2];
#pragma unroll
                for (int sp = 0; sp < 2; ++sp) { float a[8];
#pragma unroll
                    for (int j = 0; j < 8; ++j) a[j] = __builtin_amdgcn_exp2f(S0[8 * sp + j]) - lam * __builtin_amdgcn_exp2f(S1[8 * sp + j]);
                    u32x4 w; w.x = pk2(a[0], a[1]); w.y = pk2(a[2], a[3]); w.z = pk2(a[4], a[5]); w.w = pk2(a[6], a[7]);
                    pa[sp] = __builtin_bit_cast(bf16x8, w); }
#pragma unroll
                for (int d = 0; d < 4; ++d)
#pragma unroll
                    for (int sp = 0; sp < 2; ++sp) {
                        const unsigned char* vp = Vs + (d * 32 + r32) * VS_STRIDE + (kb * 32 + 16 * sp + 4 * hi) * 2;
                        const s16x4 lo = *(const s16x4*)vp, hh = *(const s16x4*)(vp + 16);
                        const bf16x8 vf = (bf16x8){lo[0], lo[1], lo[2], lo[3], hh[0], hh[1], hh[2], hh[3]};
                        O[d] = __builtin_amdgcn_mfma_f32_32x32x16_bf16(vf, pa[sp], O[d], 0, 0, 0);
                    }
            }
        }
    }
    if (PASS == 1) {
        l0 += __shfl_xor(l0, 32); l1 += __shfl_xor(l1, 32);
        if (hi == 0) { A.STATS[(size_t)qrow * 8 + h * 2] = m0 + __log2f(l0); A.STATS[(size_t)qrow * 8 + h * 2 + 1] = m1 + __log2f(l1); }
    } else {
        float ss = 0.f;
#pragma unroll
        for (int d = 0; d < 4; ++d)
#pragma unroll
            for (int r = 0; r < 16; ++r) ss += O[d][r] * O[d][r];
        ss += __shfl_xor(ss, 32);
        const float sc = rsqrtf(ss * (1.f / 128.f) + EPS) * A.lamp[2];
        bf16_t* op = A.MIX + (size_t)qrow * DM + h * 128;
#pragma unroll
        for (int d = 0; d < 4; ++d)
#pragma unroll
            for (int g = 0; g < 4; ++g) { const int dv = d * 32 + 8 * g + 4 * hi; const f32x4 w = *(const f32x4*)(A.subw + dv);
                u32x2 pk; pk.x = pk2(O[d][4 * g] * sc * w[0], O[d][4 * g + 1] * sc * w[1]); pk.y = pk2(O[d][4 * g + 2] * sc * w[2], O[d][4 * g + 3] * sc * w[3]);
                *(u32x2*)(op + dv) = pk; }
    }
}
template <int PASS> __global__ void __launch_bounds__(512, 2) k_attn(AttnArgs A) {
    __shared__ __attribute__((aligned(16))) unsigned char lds[64 * KS_STRIDE + 128 * VS_STRIDE];
    for (int u = blockIdx.x; u < A.nunits; u += gridDim.x) attn_unit<PASS>(lds, A, u);
}

constexpr int LS = 72;
__device__ __forceinline__ int hg_row(int b, int dir, int cs, int i) {
    int p = cs * 64 + i;
    if (p < CTX) return MLAT + b * CTX + (dir ? CTX - 1 - p : p);
    p -= CTX; return b * SEQ + (dir ? SEQ - 1 - p : p);
}
__device__ __forceinline__ f32x4 mm_tile(const bf16_t* A, const bf16_t* Bt, int tm, int tn, int lane, f32x4 acc) {
    const int r = lane & 15, q = lane >> 4;
#pragma unroll
    for (int ks = 0; ks < 2; ++ks) {
        const bf16x8 a = *(const bf16x8*)(A + (tm * 16 + r) * LS + ks * 32 + q * 8), b = *(const bf16x8*)(Bt + (tn * 16 + r) * LS + ks * 32 + q * 8);
        acc = __builtin_amdgcn_mfma_f32_16x16x32_bf16(a, b, acc, 0, 0, 0);
    }
    return acc;
}
struct HgArgs { const bf16_t* QH; const bf16_t* VH; const bf16_t* OG; const float* GF; const float* GB; bf16_t* L; float* DC; bf16_t* MIX; const float* wn; const float* lb; int nunits, pad; };
__global__ void __launch_bounds__(512) k_hgrn_h1(HgArgs A) {
    __shared__ __attribute__((aligned(16))) bf16_t K2t[64 * LS]; __shared__ __attribute__((aligned(16))) bf16_t Vt[64 * LS]; __shared__ float part[8][64];
    const int tid = threadIdx.x, lane = tid & 63, wid = tid >> 6, d = tid & 63, p8 = tid >> 6;
    for (int unit = blockIdx.x; unit < A.nunits; unit += gridDim.x) {
        const int seq = unit / NCH, cs = unit % NCH, dir = seq & 1, bh = seq >> 1, b = bh >> 2, h = bh & 3;
        const float* G = dir ? A.GB : A.GF; const float lbv = A.lb[dir * 256 + h * 64 + d];
        float g[8], c[8]; int rows[8];
#pragma unroll
        for (int e = 0; e < 8; ++e) { rows[e] = hg_row(b, dir, cs, 8 * p8 + e); g[e] = log_forget(G[(size_t)rows[e] * 256 + h * 64 + d], lbv); }
        c[0] = g[0];
#pragma unroll
        for (int e = 1; e < 8; ++e) c[e] = c[e - 1] + g[e];
        __syncthreads();
        part[p8][d] = c[7];
        __syncthreads();
        float off = 0.f, tot = 0.f;
#pragma unroll
        for (int p = 0; p < 8; ++p) { const float x = part[p][d]; tot += x; if (p < p8) off += x; }
#pragma unroll
        for (int e = 0; e < 8; ++e) { const float cc = c[e] + off; const float k = -expm1f(g[e]); K2t[d * LS + 8 * p8 + e] = f2bf(k * __expf(tot - cc)); }
#pragma unroll
        for (int e = 0; e < 8; ++e) Vt[d * LS + 8 * p8 + e] = A.VH[(size_t)rows[e] * 256 + h * 64 + d];
        if (p8 == 0) A.DC[(size_t)unit * 64 + d] = __expf(tot);
        __syncthreads();
        const int tm = wid >> 1; bf16_t* Lp = A.L + (size_t)unit * 4096;
#pragma unroll
        for (int j = 0; j < 2; ++j) { const int tn = 2 * (wid & 1) + j; f32x4 acc = {0.f, 0.f, 0.f, 0.f};
            acc = mm_tile(Vt, K2t, tm, tn, lane, acc);
#pragma unroll
            for (int r = 0; r < 4; ++r) Lp[(tm * 16 + 4 * (lane >> 4) + r) * 64 + tn * 16 + (lane & 15)] = f2bf(acc[r]); }
    }
}
__global__ void __launch_bounds__(256) k_hgrn_scan(bf16_t* L, const float* DC) {
    const int idx = blockIdx.x * 256 + threadIdx.x, seq = idx >> 12, e = idx & 4095, d = e & 63;
    float S = 0.f;
    for (int cs = 0; cs < NCH; ++cs) { const size_t o = ((size_t)seq * NCH + cs) * 4096 + e; const float lv = bf2f(L[o]); L[o] = f2bf(S); S = DC[((size_t)seq * NCH + cs) * 64 + d] * S + lv; }
}
__global__ void __launch_bounds__(512) k_hgrn_h3(HgArgs A, int nlat) {
    __shared__ __attribute__((aligned(16))) bf16_t Q1[64 * LS]; __shared__ __attribute__((aligned(16))) bf16_t K1[64 * LS]; __shared__ __attribute__((aligned(16))) bf16_t Q2[64 * LS];
    __shared__ __attribute__((aligned(16))) bf16_t Vt[64 * LS]; __shared__ __attribute__((aligned(16))) bf16_t St[64 * LS]; __shared__ __attribute__((aligned(16))) bf16_t Sm[64 * LS];
    __shared__ float part[8][64]; __shared__ float Ol[64][65];
    const int tid = threadIdx.x, lane = tid & 63, wid = tid >> 6, d = tid & 63, p8 = tid >> 6;
    for (int unit = blockIdx.x; unit < A.nunits; unit += gridDim.x) {
        int b, h, J; bool ctx;
        if (unit < nlat) { ctx = false; b = unit >> 7; h = (unit >> 5) & 3; J = unit & 31; } else { const int uc = unit - nlat; ctx = true; b = uc >> 4; h = (uc >> 2) & 3; J = uc & 3; }
        for (int dir = 0; dir < 2; ++dir) {
            const int cs = ctx ? (dir ? 3 - J : J) : (dir ? 4 + 31 - J : 4 + J);
            const int seq = (b * 4 + h) * 2 + dir; const float* G = dir ? A.GB : A.GF; const float lbv = A.lb[dir * 256 + h * 64 + d];
            float g[8], c[8]; int rows[8];
#pragma unroll
            for (int e = 0; e < 8; ++e) { rows[e] = hg_row(b, dir, cs, 8 * p8 + e); g[e] = log_forget(G[(size_t)rows[e] * 256 + h * 64 + d], lbv); }
            c[0] = g[0];
#pragma unroll
            for (int e = 1; e < 8; ++e) c[e] = c[e - 1] + g[e];
            __syncthreads();
            part[p8][d] = c[7];
            __syncthreads();
            float off = 0.f, R = 0.f;
#pragma unroll
            for (int p = 0; p < 8; ++p) { const float x = part[p][d]; if (p < 4) R += x; if (p < p8) off += x; }
            const bf16_t* Sp = A.L + ((size_t)seq * NCH + cs) * 4096;
#pragma unroll
            for (int e = 0; e < 8; ++e) { const int i = 8 * p8 + e; const float cc = c[e] + off, k = -expm1f(g[e]), q = bf2f(A.QH[(size_t)rows[e] * 256 + h * 64 + d]);
                Q1[i * LS + d] = f2bf(q * __expf(cc - R)); K1[i * LS + d] = f2bf(k * __expf(R - cc)); Q2[i * LS + d] = f2bf(q * __expf(cc));
                Vt[d * LS + i] = A.VH[(size_t)rows[e] * 256 + h * 64 + d];
                St[i * LS + d] = Sp[i * 64 + d]; }
            __syncthreads();
            const int tm = wid >> 1, q4 = lane >> 4, r16 = lane & 15;
#pragma unroll
            for (int j = 0; j < 2; ++j) { const int tn = 2 * (wid & 1) + j; f32x4 acc = {0.f, 0.f, 0.f, 0.f};
                acc = mm_tile(Q1, K1, tm, tn, lane, acc);
#pragma unroll
                for (int r = 0; r < 4; ++r) { const int t = tm * 16 + 4 * q4 + r, s = tn * 16 + r16; Sm[t * LS + s] = f2bf(s <= t ? acc[r] : 0.f); } }
            __syncthreads();
#pragma unroll
            for (int j = 0; j < 2; ++j) { const int tn = 2 * (wid & 1) + j; f32x4 acc = {0.f, 0.f, 0.f, 0.f};
                acc = mm_tile(Sm, Vt, tm, tn, lane, acc);
                acc = mm_tile(Q2, St, tm, tn, lane, acc);
#pragma unroll
                for (int r = 0; r < 4; ++r) { const int t = tm * 16 + 4 * q4 + r, v = tn * 16 + r16;
                    if (dir == 0) Ol[t][v] = acc[r]; else Ol[63 - t][v] += acc[r]; } }
            __syncthreads();
        }
        {
            const int tk = tid >> 3, v0 = (tid & 7) * 8; const int row = ctx ? MLAT + b * CTX + J * 64 + tk : b * SEQ + J * 64 + tk;
            float o[8], ss = 0.f;
#pragma unroll
            for (int e = 0; e < 8; ++e) { o[e] = Ol[tk][v0 + e]; ss += o[e] * o[e]; }
            ss += __shfl_xor(ss, 1); ss += __shfl_xor(ss, 2); ss += __shfl_xor(ss, 4);
            const float rstd = rsqrtf(ss * (1.f / 64.f) + EPS);
            const u32x4 ogw = *(const u32x4*)(A.OG + (size_t)row * 256 + h * 64 + v0);
            const unsigned og[4] = {ogw.x, ogw.y, ogw.z, ogw.w};
#pragma unroll
            for (int e = 0; e < 8; ++e) { const float gt = __uint_as_float((e & 1) ? (og[e >> 1] & 0xffff0000u) : (og[e >> 1] << 16)); o[e] = o[e] * rstd * A.wn[v0 + e] * gt; }
            store8_bf16(A.MIX + (size_t)row * DM + 512 + h * 64 + v0, o);
        }
    }
}

__global__ void __launch_bounds__(512) k_dftprep(const bf16_t* UU, int rowbase, int L, bf16_t* Bt) {
    __shared__ float F[32][256]; __shared__ float T[2][64];
    const int tid = threadIdx.x, ntile = L / 32, b = blockIdx.x / ntile, k0 = (blockIdx.x % ntile) * 32, hL = L / 2;
    if (tid < 64) { float s, c; sincospif((float)tid / 32.f, &s, &c); T[0][tid] = c * 0.125f; T[1][tid] = s * 0.125f; }
    for (int i = tid; i < 32 * 256; i += 512) { const int r = i >> 8, ch = i & 255, kk = k0 + r; const int k = kk <= hL ? kk : kk - hL;
        const float a = bf2f(UU[(size_t)(rowbase + b * L + k) * 256 + ch]);
        float f;
        if (k == 0 || k == hL) f = a; else { const float bb = bf2f(UU[(size_t)(rowbase + b * L + L - k) * 256 + ch]); f = kk <= hL ? a + bb : a - bb; }
        F[r][ch] = f; }
    __syncthreads();
    const int ch = tid >> 1, half = tid & 1, g = ch >> 6, cp = ch & 63;
    float o[16];
#pragma unroll
    for (int i = 0; i < 16; ++i) o[i] = 0.f;
    for (int c = 0; c < 64; ++c) { const int ph = (c * cp) & 63; const float tc = T[0][ph], ts = T[1][ph];
#pragma unroll
        for (int i = 0; i < 16; ++i) { const int r = 16 * half + i; o[i] += F[r][g * 64 + c] * ((k0 + r) <= hL ? tc : ts); } }
    bf16_t* op = Bt + (size_t)(b * 256 + ch) * L + k0 + 16 * half;
    store8_bf16(op, o); store8_bf16(op + 8, o + 8);
}

__global__ void __launch_bounds__(256) k_convgate(const bf16_t* U, int nrows, int seqlen, const float* conv_w, const float* conv_b, bf16_t* G, int grow0) {
    const int idx = blockIdx.x * 256 + threadIdx.x; const int r = idx / 352, j0 = (idx % 352) * 8; if (r >= nrows) return;
    const int t = r % seqlen; const bool hp = t > 0, hn = t < seqlen - 1;
    const int cg = (j0 >> 7) * 256 + (j0 & 127), cv = cg + 128;
    float og[8];
    const bf16_t* up = U + (size_t)r * 5632;
    u32x4 z; z.x = z.y = z.z = z.w = 0u;
    const u32x4 g1 = *(const u32x4*)(up + cg), v1 = *(const u32x4*)(up + cv);
    const u32x4 g0 = hp ? *(const u32x4*)(up - 5632 + cg) : z, v0 = hp ? *(const u32x4*)(up - 5632 + cv) : z;
    const u32x4 g2 = hn ? *(const u32x4*)(up + 5632 + cg) : z, v2 = hn ? *(const u32x4*)(up + 5632 + cv) : z;
    const unsigned G0[4] = {g0.x, g0.y, g0.z, g0.w}, G1[4] = {g1.x, g1.y, g1.z, g1.w}, G2[4] = {g2.x, g2.y, g2.z, g2.w};
    const unsigned V0[4] = {v0.x, v0.y, v0.z, v0.w}, V1[4] = {v1.x, v1.y, v1.z, v1.w}, V2[4] = {v2.x, v2.y, v2.z, v2.w};
#pragma unroll
    for (int e = 0; e < 8; ++e) {
        const int jg = j0 + e, jv = DFF + j0 + e;
#define UNPK(W) __uint_as_float((e & 1) ? (W[e >> 1] & 0xffff0000u) : (W[e >> 1] << 16))
        const float a = conv_w[jg] * UNPK(G0) + conv_w[2 * DFF + jg] * UNPK(G1) + conv_w[4 * DFF + jg] * UNPK(G2) + conv_b[jg];
        const float c = conv_w[jv] * UNPK(V0) + conv_w[2 * DFF + jv] * UNPK(V1) + conv_w[4 * DFF + jv] * UNPK(V2) + conv_b[jv];
#undef UNPK
        og[e] = silu_f(a) * c;
    }
    store8_bf16(G + (size_t)(grow0 + r) * DFF + j0, og);
}

#define LAUNCH_CHECK(what) do { hipError_t e_ = hipPeekAtLastError(); if (e_ != hipSuccess) fprintf(stderr, "kernel_launch: %s failed: %s\n", what, hipGetErrorName(e_)); } while (0)
template <class Epi> static void launch_gemm(const pg8::Gemm& g, const Epi& E, hipStream_t stream) {
    static bool attr = false;
    if (!attr) { (void)hipFuncSetAttribute((const void*)k_gemm<Epi>, hipFuncAttributeMaxDynamicSharedMemorySize, pg8::STAGE_BYTES); attr = true; }
    const int units = (g.M / 256) * (g.N / 256); const int grid = units < 256 ? units : 256;
    hipLaunchKernelGGL(k_gemm<Epi>, dim3(grid), dim3(512), pg8::STAGE_BYTES, stream, g, E);
    LAUNCH_CHECK("gemm");
}

extern "C" void kernel_launch(void* const* d_in, const int* in_sizes, int n_in, void* d_out, int out_size, void* d_ws, size_t ws_size, hipStream_t stream) {
    if (n_in != 20 || ws_size < WS_END || out_size != MLAT * DM) { fprintf(stderr, "kernel_launch: unexpected sizes (n_in %d, ws %zu, out %d)\n", n_in, ws_size, out_size); return; }
    const float* x = (const float*)d_in[0]; const float* c = (const float*)d_in[1]; const float* ctx = (const float*)d_in[2]; const float* c_ctx = (const float*)d_in[3];
    const float* w_ada = (const float*)d_in[4]; const float* b_ada = (const float*)d_in[5]; const float* norm1_w = (const float*)d_in[6]; const float* norm2_w = (const float*)d_in[7];
    const float* w_in = (const float*)d_in[8]; const float* lam_qk = (const float*)d_in[9]; const float* subln_w = (const float*)d_in[10]; const float* lb_param = (const float*)d_in[11];
    const float* hgrn_norm_w = (const float*)d_in[12]; const float* w_fnet = (const float*)d_in[13]; const float* w_out = (const float*)d_in[14]; const float* w_up = (const float*)d_in[15];
    const float* conv_w = (const float*)d_in[16]; const float* conv_b = (const float*)d_in[17]; const float* w_down = (const float*)d_in[18]; const float* final_norm_w = (const float*)d_in[19];
    unsigned char* ws = (unsigned char*)d_ws; float* out = (float*)d_out;
    float* MOD = (float*)(ws + WS_MOD); float* LAM = (float*)(ws + WS_LAM); float* LB = (float*)(ws + WS_LB); float* ROPE = (float*)(ws + WS_ROPE); float* STATS = (float*)(ws + WS_STATS);
    bf16_t* WIN = (bf16_t*)(ws + WS_WIN); bf16_t* WOUT = (bf16_t*)(ws + WS_WOUT); bf16_t* WUP = (bf16_t*)(ws + WS_WUP); bf16_t* WDOWN = (bf16_t*)(ws + WS_WDOWN);
    bf16_t* DFT = (bf16_t*)(ws + WS_DFT); bf16_t* DFTC = (bf16_t*)(ws + WS_DFTC); float* CTXX = (float*)(ws + WS_CTXX); bf16_t* H = (bf16_t*)(ws + WS_H); bf16_t* MIX = H;
    bf16_t* QA = (bf16_t*)(ws + WS_QA); bf16_t* KC = (bf16_t*)(ws + WS_KC); bf16_t* VT = (bf16_t*)(ws + WS_VT); bf16_t* QH = (bf16_t*)(ws + WS_QH); bf16_t* VH = (bf16_t*)(ws + WS_VH);
    bf16_t* OG = (bf16_t*)(ws + WS_OG); bf16_t* UU = (bf16_t*)(ws + WS_UU); float* GF = (float*)(ws + WS_GF); float* GB = (float*)(ws + WS_GB);
    bf16_t* LBUF = (bf16_t*)(ws + WS_L); float* DC = (float*)(ws + WS_DC); bf16_t* BT = (bf16_t*)(ws + WS_BT); bf16_t* BTC = (bf16_t*)(ws + WS_BTC); float* FOLD = (float*)(ws + WS_FOLD);
    bf16_t* GBUF = (bf16_t*)(ws + WS_G); bf16_t* UCH = (bf16_t*)(ws + WS_UCH);

    hipLaunchKernelGGL(k_small, dim3(1), dim3(256), 0, stream, lam_qk, lb_param, LAM, LB, ROPE);
    hipLaunchKernelGGL(k_adaln, dim3(192), dim3(512), 0, stream, c, c_ctx, w_ada, b_ada, MOD);
    hipLaunchKernelGGL(k_fold, dim3(4, 256, 2), dim3(256), 0, stream, w_fnet, w_out, FOLD);
    for (int li = 0; li < 2; ++li) {
        hipLaunchKernelGGL(k_transpose, dim3(PW / 32, DM / 32), dim3(256), 0, stream, w_in + (size_t)li * DM * PW, (const float*)nullptr, WIN + (size_t)li * PW * DM, DM, DM, PW, 0);
        hipLaunchKernelGGL(k_transpose, dim3(DM / 32, DM / 32), dim3(256), 0, stream, w_out + (size_t)li * DM * DM, (const float*)(FOLD + (size_t)li * 256 * DM), WOUT + (size_t)li * DM * DM, 768, DM, DM, 0);
    }
    hipLaunchKernelGGL(k_dftgen, dim3(SEQ * SEQ / 256), dim3(256), 0, stream, DFT, SEQ);
    hipLaunchKernelGGL(k_dftgen, dim3(CTX * CTX / 256), dim3(256), 0, stream, DFTC, CTX);
    LAUNCH_CHECK("prologue");

    for (int li = 0; li < 2; ++li) {
        const bool last = li == 1; const float* mod = MOD + (size_t)li * 9 * 6144;
        const float* xl = li == 0 ? x : out; const float* xc = li == 0 ? ctx : CTXX;
        hipLaunchKernelGGL(k_transpose, dim3(2 * DFF / 32, DM / 32), dim3(256), 0, stream, w_up + (size_t)li * DM * 2 * DFF, (const float*)nullptr, WUP, DM, DM, 2 * DFF, 1);
        hipLaunchKernelGGL(k_transpose, dim3(DM / 32, DFF / 32), dim3(256), 0, stream, w_down + (size_t)li * DFF * DM, (const float*)nullptr, WDOWN, DFF, DFF, DM, 0);
        hipLaunchKernelGGL(k_normmod, dim3(MTOT / 8), dim3(512), 0, stream, xl, xc, norm1_w + li * DM, mod, H, 0, MTOT);
        { pg8::Gemm g{H, WIN + (size_t)li * PW * DM, MTOT, PW, DM}; EpiInProj E{QA, KC, VT, QH, VH, OG, UU, GF, GB, ROPE, LB + li * 512}; launch_gemm(g, E, stream); }
        { AttnArgs A{QA, KC, VT, STATS, MIX, LAM + li, subln_w + li * 128, 256, last ? 256 : 288};
          hipLaunchKernelGGL(k_attn<1>, dim3(A.nunits), dim3(512), 0, stream, A);
          hipLaunchKernelGGL(k_attn<2>, dim3(A.nunits), dim3(512), 0, stream, A); LAUNCH_CHECK("attn"); }
        { HgArgs A{QH, VH, OG, GF, GB, LBUF, DC, MIX, hgrn_norm_w + li * 64, LB + li * 512, 64 * NCH};
          hipLaunchKernelGGL(k_hgrn_h1, dim3(1024), dim3(512), 0, stream, A);
          hipLaunchKernelGGL(k_hgrn_scan, dim3(64 * 4096 / 256), dim3(256), 0, stream, LBUF, (const float*)DC);
          A.nunits = last ? 1024 : 1024 + 128;
          hipLaunchKernelGGL(k_hgrn_h3, dim3(A.nunits), dim3(512), 0, stream, A, 1024); LAUNCH_CHECK("hgrn"); }
        hipLaunchKernelGGL(k_dftprep, dim3(NB * SEQ / 32), dim3(512), 0, stream, (const bf16_t*)UU, 0, SEQ, BT);
        { pg8::Gemm g{DFT, BT, SEQ, NB * 256, SEQ}; EpiDft E{MIX, 0, SEQ}; launch_gemm(g, E, stream); }
        if (!last) {
            hipLaunchKernelGGL(k_dftprep, dim3(NB * CTX / 32), dim3(512), 0, stream, (const bf16_t*)UU, MLAT, CTX, BTC);
            pg8::Gemm g{DFTC, BTC, CTX, NB * 256, CTX}; EpiDft E{MIX, MLAT, CTX}; launch_gemm(g, E, stream);
        }
        const int Mff = last ? MLAT : MTOT;
        { pg8::Gemm g{MIX, WOUT + (size_t)li * DM * DM, Mff, DM, DM}; EpiResid E{xl, xc, out, CTXX, mod, 2048}; launch_gemm(g, E, stream); }
        hipLaunchKernelGGL(k_normmod, dim3(Mff / 8), dim3(512), 0, stream, (const float*)out, (const float*)CTXX, norm2_w + li * DM, mod, H, 3072, Mff);
        for (int r0 = 0; r0 < Mff; r0 += 4096) {
            const int nr = (Mff - r0) < 4096 ? (Mff - r0) : 4096;
            pg8::Gemm g{H + (size_t)r0 * DM, WUP, nr, 2 * DFF, DM}; EpiStoreBf16 E{UCH, 2 * DFF}; launch_gemm(g, E, stream);
            hipLaunchKernelGGL(k_convgate, dim3(nr * 352 / 256), dim3(256), 0, stream, (const bf16_t*)UCH, nr, r0 < MLAT ? SEQ : CTX, conv_w + (size_t)li * 3 * 2 * DFF, conv_b + (size_t)li * 2 * DFF, GBUF, r0);
        }
        { pg8::Gemm g{GBUF, WDOWN, Mff, DM, DFF}; EpiResid E{out, CTXX, out, CTXX, mod, 5120}; launch_gemm(g, E, stream); }
        LAUNCH_CHECK("layer");
    }
    hipLaunchKernelGGL(k_finalnorm, dim3(MLAT / 8), dim3(512), 0, stream, out, final_norm_w, MLAT);
    LAUNCH_CHECK("final");
}
```

```cpp
#include <hip/hip_runtime.h>
#include <hip/hip_cooperative_groups.h>
#include <cstdio>
#include <cstdint>
__device__ __forceinline__ int tid_opaque() { int t = threadIdx.x; asm volatile("" : "+v"(t)); return t; }
namespace pg8 {
#define PG8_LAS __attribute__((address_space(3)))
typedef unsigned short bf16_t;
typedef short bf16x8 __attribute__((ext_vector_type(8)));
typedef float f32x4 __attribute__((ext_vector_type(4)));
typedef unsigned u32x4 __attribute__((ext_vector_type(4)));
constexpr int BM = 256, BK = 64, HALF = 128, HTB = HALF * BK * 2  , STAGE_BYTES = 8 * HTB, NXCD = 8, WGM = 8;

__host__ __device__ __forceinline__ int lds_byte(int r, int c) { const int st = (r >> 4) * 2 + (c >> 5), rr = r & 15, cc = c & 31, ob = rr * 64 + cc * 2; return st * 1024 + (ob ^ (((ob >> 9) & 1) << 5)); }
__host__ __device__ __forceinline__ void stage_rc(int b, int& R, int& C) { const int st = b / 1024, sb = b % 1024, swz = sb ^ (((sb >> 9) & 1) << 5); R = (st >> 1) * 16 + swz / 64; C = (st & 1) * 32 + (swz % 64) / 2; }
__host__ __device__ __forceinline__ int perm32(int rho) { const int n = rho >> 4, i = rho & 15; return 8 * (i >> 2) + 4 * n + (i & 3); }

struct Unit { int pm, pn; };
struct Gemm { const bf16_t* A; const bf16_t* Bt; int M, N, K, pad; };

struct StaticOrder {
    int nM, nN, nwg, G, c;
    __host__ __device__ void init(int M, int N, int G_, int c_) { nM = M / BM; nN = N / BM; nwg = nM * nN; G = G_; c = c_; }
    __host__ __device__ bool next(int i, Unit& u) const {
        const long L = (long)i * G + c; if (L >= nwg) return false;
        int wgid = (int)L; { const int q = nwg / NXCD, r = nwg % NXCD, xcd = wgid % NXCD, off = wgid / NXCD; wgid = (xcd < r ? xcd * (q + 1) : r * (q + 1) + (xcd - r) * q) + off; }
        const int nig = WGM * nN, gid = wgid / nig, fm = gid * WGM, gsz = (nM - fm) < WGM ? (nM - fm) : WGM;
        u.pm = fm + ((wgid % nig) % gsz); u.pn = (wgid % nig) / gsz; return true;
    }
    __device__ __forceinline__ void a_ready(const Unit&) const {}
    __device__ __forceinline__ void done(const Unit&) const {}
};

template <class Epi, class Sched, bool ALIGN_EPI = false, bool SP2 = false>
__device__ __forceinline__ void gemm_phase(PG8_LAS unsigned char* lds, const Gemm g, const Sched& S, const Epi& E) {
    const int tid = tid_opaque(), wid = __builtin_amdgcn_readfirstlane(tid >> 6), lane = tid & 63, wr = wid >> 2, wc = wid & 3, fr = lane & 15, fq = lane >> 4;
    const int K = g.K, nt = K / BK;
    unsigned voffA[2], voffB[2];
#pragma unroll
    for (int i = 0; i < 2; ++i) { int R, C; stage_rc(tid * 16 + i * 8192, R, C); const int Rb = Epi::PERM ? ((R & ~31) + perm32(R & 31)) : R;
        voffA[i] = (unsigned)(R * K + C) * 2u; voffB[i] = (unsigned)(Rb * K + C) * 2u; }
    const size_t kstep = (size_t)(BK * 2);
    const size_t hstep = (size_t)HALF * K * 2;
    const size_t tstep = 2 * hstep;
    const unsigned ldsw = (unsigned)wid * 1024u;
    const int aoff = lds_byte(wr * 64 + fr, fq * 8), boff = lds_byte(wc * 32 + fr, fq * 8);
#define PG8_SA(b, h) (((b) * 2 + (h)) * HTB)
#define PG8_SB(b, h) ((4 + (b) * 2 + (h)) * HTB)
#define PG8_STAGE(bufoff, gbase, voff) do { _Pragma("unroll") for (int _i = 0; _i < 2; ++_i) \
        __builtin_amdgcn_global_load_lds((const unsigned*)((const char*)(gbase) + (voff)[_i]), (PG8_LAS unsigned*)(lds + (bufoff) + ldsw + _i * 8192), 16, 0, 0); } while (0)
#define PG8_LDA(dst, b, h) do { _Pragma("unroll") for (int m = 0; m < 4; ++m) _Pragma("unroll") for (int k = 0; k < 2; ++k) dst[m][k] = *(const PG8_LAS bf16x8*)(lds + PG8_SA(b, h) + aoff + m * 2048 + k * 1024); } while (0)
#define PG8_LDB(dst, b, h) do { _Pragma("unroll") for (int n = 0; n < 2; ++n) _Pragma("unroll") for (int k = 0; k < 2; ++k) dst[n][k] = *(const PG8_LAS bf16x8*)(lds + PG8_SB(b, h) + boff + n * 2048 + k * 1024); } while (0)
#define PG8_MMA(ai, bj, At, Bt) do { __builtin_amdgcn_s_setprio(1); _Pragma("unroll") for (int m = 0; m < 4; ++m) _Pragma("unroll") for (int n = 0; n < 2; ++n) _Pragma("unroll") for (int k = 0; k < 2; ++k) \
        acc[ai][bj][m][n] = __builtin_amdgcn_mfma_f32_16x16x32_bf16(Bt[n][k], At[m][k], acc[ai][bj][m][n], 0, 0, 0); __builtin_amdgcn_s_setprio(0); } while (0)
#define PG8_WAIT_V(n) asm volatile("s_waitcnt vmcnt(" #n ")" ::: "memory")
#define PG8_WAIT_L(n) asm volatile("s_waitcnt lgkmcnt(" #n ")" ::: "memory")
#define PG8_BAR __builtin_amdgcn_s_barrier()
#define PG8_SCHED __builtin_amdgcn_sched_barrier(0)
    Unit cur, nxt; int ui = 0;
    if (!S.next(0, cur)) return;
    f32x4 acc[2][2][4][2];
#pragma unroll
    for (int a = 0; a < 2; ++a)
#pragma unroll
        for (int b = 0; b < 2; ++b)
#pragma unroll
            for (int m = 0; m < 4; ++m)
#pragma unroll
                for (int n = 0; n < 2; ++n) acc[a][b][m][n] = (f32x4){0.f, 0.f, 0.f, 0.f};
    bf16x8 At[4][2], B0[2][2], B1[2][2];
    const char* cA = (const char*)g.A + (size_t)cur.pm * tstep; const char* cB = (const char*)g.Bt + (size_t)cur.pn * tstep;
    S.a_ready(cur);
    if constexpr (SP2) {
        PG8_STAGE(PG8_SB(0, 0), cB, voffB); PG8_STAGE(PG8_SB(0, 1), cB + hstep, voffB); PG8_STAGE(PG8_SA(0, 0), cA, voffA); PG8_STAGE(PG8_SA(0, 1), cA + hstep, voffA);
        if (wr == 1) PG8_BAR;
        PG8_WAIT_V(2); PG8_BAR;
        PG8_STAGE(PG8_SB(1, 0), cB + kstep, voffB); PG8_STAGE(PG8_SA(1, 0), cA + kstep, voffA); PG8_STAGE(PG8_SB(1, 1), cB + hstep + kstep, voffB);
        PG8_WAIT_V(6); PG8_BAR;
    } else {
        PG8_STAGE(PG8_SB(0, 0), cB, voffB); PG8_STAGE(PG8_SA(0, 0), cA, voffA); PG8_STAGE(PG8_SB(0, 1), cB + hstep, voffB); PG8_STAGE(PG8_SA(0, 1), cA + hstep, voffA);
        if (wr == 1) PG8_BAR;
        PG8_WAIT_V(4); PG8_BAR;
        PG8_STAGE(PG8_SB(1, 0), cB + kstep, voffB); PG8_STAGE(PG8_SA(1, 0), cA + kstep, voffA); PG8_STAGE(PG8_SB(1, 1), cB + hstep + kstep, voffB);
        PG8_WAIT_V(6); PG8_BAR;
    }
    for (;;) {
        const bool has_next = S.next(ui + 1, nxt);
        const char* nA = has_next ? (const char*)g.A + (size_t)nxt.pm * tstep : cA; const char* nB = has_next ? (const char*)g.Bt + (size_t)nxt.pn * tstep : cB;
        for (int t = 0; t < nt; t += 2) {
            const bool last = (t == nt - 2);
            const char* a1 = cA + (size_t)(t + 1) * kstep;
            const char* a2 = last ? nA : cA + (size_t)(t + 2) * kstep; const char* b2 = last ? nB : cB + (size_t)(t + 2) * kstep;
            const char* a3 = a2 + kstep; const char* b3 = b2 + kstep;
            if (last && has_next) S.a_ready(nxt);
            if constexpr (SP2) {
            PG8_LDB(B0, 0, 0); PG8_LDB(B1, 0, 1); PG8_SCHED; PG8_LDA(At, 0, 0); PG8_STAGE(PG8_SA(1, 1), a1 + hstep, voffA);
            PG8_WAIT_V(8); PG8_WAIT_L(0); PG8_BAR; PG8_MMA(0, 0, At, B0); PG8_MMA(0, 1, At, B1); PG8_BAR; PG8_SCHED;
            PG8_LDA(At, 0, 1); PG8_STAGE(PG8_SB(0, 0), b2, voffB); PG8_STAGE(PG8_SB(0, 1), b2 + hstep, voffB); PG8_STAGE(PG8_SA(0, 0), a2, voffA);
            PG8_WAIT_V(8); PG8_WAIT_L(0); PG8_BAR; PG8_MMA(1, 0, At, B0); PG8_MMA(1, 1, At, B1); PG8_BAR; PG8_SCHED;
            PG8_LDB(B0, 1, 0); PG8_LDB(B1, 1, 1); PG8_SCHED; PG8_LDA(At, 1, 0); PG8_STAGE(PG8_SA(0, 1), a2 + hstep, voffA);
            PG8_WAIT_V(8); PG8_WAIT_L(0); PG8_BAR; PG8_MMA(0, 0, At, B0); PG8_MMA(0, 1, At, B1); PG8_BAR; PG8_SCHED;
            PG8_LDA(At, 1, 1); PG8_STAGE(PG8_SB(1, 0), b3, voffB); PG8_STAGE(PG8_SB(1, 1), b3 + hstep, voffB); PG8_STAGE(PG8_SA(1, 0), a3, voffA);
            PG8_WAIT_V(8); PG8_WAIT_L(0); PG8_BAR; PG8_MMA(1, 0, At, B0); PG8_MMA(1, 1, At, B1); PG8_BAR; PG8_SCHED;
            } else {
            PG8_LDB(B0, 0, 0); PG8_SCHED; PG8_LDA(At, 0, 0); PG8_STAGE(PG8_SA(1, 1), a1 + hstep, voffA);
            PG8_WAIT_L(8); PG8_BAR; PG8_WAIT_L(0); PG8_MMA(0, 0, At, B0); PG8_BAR; PG8_SCHED;
            PG8_LDB(B1, 0, 1); PG8_STAGE(PG8_SB(0, 0), b2, voffB);
            PG8_BAR; PG8_WAIT_L(0); PG8_MMA(0, 1, At, B1); PG8_BAR;
            PG8_LDA(At, 0, 1); PG8_STAGE(PG8_SA(0, 0), a2, voffA);
            PG8_BAR; PG8_WAIT_L(0); PG8_MMA(1, 0, At, B0); PG8_BAR; PG8_SCHED;
            PG8_STAGE(PG8_SB(0, 1), b2 + hstep, voffB);
            PG8_WAIT_V(6); PG8_BAR; PG8_MMA(1, 1, At, B1); PG8_BAR;
            PG8_LDB(B0, 1, 0); PG8_SCHED; PG8_LDA(At, 1, 0); PG8_STAGE(PG8_SA(0, 1), a2 + hstep, voffA);
            PG8_WAIT_L(8); PG8_BAR; PG8_WAIT_L(0); PG8_MMA(0, 0, At, B0); PG8_BAR; PG8_SCHED;
            PG8_LDB(B1, 1, 1); PG8_STAGE(PG8_SB(1, 0), b3, voffB);
            PG8_BAR; PG8_WAIT_L(0); PG8_MMA(0, 1, At, B1); PG8_BAR;
            PG8_LDA(At, 1, 1); PG8_STAGE(PG8_SA(1, 0), a3, voffA);
            PG8_BAR; PG8_WAIT_L(0); PG8_MMA(1, 0, At, B0); PG8_BAR; PG8_SCHED;
            PG8_STAGE(PG8_SB(1, 1), b3 + hstep, voffB);
            PG8_WAIT_V(6); PG8_BAR; PG8_MMA(1, 1, At, B1); PG8_BAR;
            }
        }
        if constexpr (ALIGN_EPI) { if (wr == 0) PG8_BAR; }
        if constexpr (!Epi::AFTER_DRAIN) { E(acc, cur, wr, wc, fr, fq); S.done(cur); }
        if (!has_next) break;
#pragma unroll
        for (int a = 0; a < 2; ++a)
#pragma unroll
            for (int b = 0; b < 2; ++b)
#pragma unroll
                for (int m = 0; m < 4; ++m)
#pragma unroll
                    for (int n = 0; n < 2; ++n) acc[a][b][m][n] = (f32x4){0.f, 0.f, 0.f, 0.f};
        cur = nxt; cA = nA; cB = nB; ++ui;
        if constexpr (ALIGN_EPI) { if (wr == 1) PG8_BAR; }
    }
    PG8_WAIT_V(0);
    if constexpr (!ALIGN_EPI) { if (wr == 0) PG8_BAR; }
    PG8_BAR;
    if constexpr (Epi::AFTER_DRAIN) { E.fused(acc, cur, wr, wc, fr, fq, lds, wid, lane); S.done(cur); }
#undef PG8_SA
#undef PG8_SB
#undef PG8_STAGE
#undef PG8_LDA
#undef PG8_LDB
#undef PG8_MMA
#undef PG8_WAIT_V
#undef PG8_WAIT_L
#undef PG8_BAR
#undef PG8_SCHED
}
}

using pg8::bf16_t; using pg8::bf16x8; using pg8::f32x4;
typedef float f32x16 __attribute__((ext_vector_type(16)));
typedef short s16x4 __attribute__((ext_vector_type(4)));
typedef unsigned u32x4 __attribute__((ext_vector_type(4)));
typedef unsigned u32x2 __attribute__((ext_vector_type(2)));
#define LAS __attribute__((address_space(3)))

constexpr int DM = 1024, NB = 8, SEQ = 2048, CTX = 256, MLAT = NB * SEQ, MCTX = NB * CTX, MTOT = MLAT + MCTX;
constexpr int PW = 3072, DFF = 2816, KEYS = SEQ + CTX, NCH = 36  ;
constexpr float EPS = 1e-6f;
constexpr float QSCALE = 0.125f * 1.4426950408889634f;

constexpr size_t MiB = 1u << 20;
constexpr size_t WS_CTL = 0;
constexpr size_t WS_MOD = 64 * 1024;
constexpr size_t WS_LAM = 512 * 1024;
constexpr size_t WS_LB = WS_LAM + 256;
constexpr size_t WS_ROPE = WS_LB + 4096;
constexpr size_t WS_STATS = 1 * MiB;
constexpr size_t WS_WIN = 4 * MiB;
constexpr size_t WS_WOUT = 16 * MiB;
constexpr size_t WS_WUP = 21 * MiB;
constexpr size_t WS_WDOWN = 32 * MiB;
constexpr size_t WS_DFT = 38 * MiB;
constexpr size_t WS_DFTC = 46 * MiB;
constexpr size_t WS_CTXX = 47 * MiB;
constexpr size_t WS_H = 55 * MiB;
constexpr size_t WS_QA = 91 * MiB;
constexpr size_t WS_KC = 109 * MiB;
constexpr size_t WS_VT = 127 * MiB;
constexpr size_t WS_QH = 145 * MiB;
constexpr size_t WS_VH = 154 * MiB;
constexpr size_t WS_OG = 163 * MiB;
constexpr size_t WS_UU = 172 * MiB;
constexpr size_t WS_GF = 181 * MiB;
constexpr size_t WS_GB = 199 * MiB;
constexpr size_t WS_L = 217 * MiB;
constexpr size_t WS_DC = 235 * MiB;
constexpr size_t WS_BT = 236 * MiB;
constexpr size_t WS_BTC = 244 * MiB;
constexpr size_t WS_FOLD = 245 * MiB;
constexpr size_t WS_G = 91 * MiB;
constexpr size_t WS_UCH = 190 * MiB;
constexpr size_t WS_END = 248 * MiB;

__device__ __forceinline__ bf16_t f2bf(float f) { unsigned u = __float_as_uint(f); return (bf16_t)((u + 0x7fffu + ((u >> 16) & 1u)) >> 16); }
__device__ __forceinline__ float bf2f(bf16_t h) { return __uint_as_float(((unsigned)h) << 16); }
__device__ __forceinline__ unsigned pk2(float lo, float hi) { return (unsigned)f2bf(lo) | ((unsigned)f2bf(hi) << 16); }
__device__ __forceinline__ float silu_f(float v) { return v / (1.f + __expf(-v)); }
__device__ __forceinline__ float wave_sum(float v) {
#pragma unroll
    for (int o = 1; o < 64; o <<= 1) v += __shfl_xor(v, o);
    return v;
}

template <class F> __device__ __forceinline__ void epi_for_each(const f32x4 (&acc)[2][2][4][2], const pg8::Unit& u, int wr, int wc, int fr, int fq, F f) {
#pragma unroll
    for (int ai = 0; ai < 2; ++ai)
#pragma unroll
        for (int m = 0; m < 4; ++m) { const int row = u.pm * 256 + ai * 128 + wr * 64 + m * 16 + fr;
#pragma unroll
            for (int bj = 0; bj < 2; ++bj) { const int col = u.pn * 256 + bj * 128 + wc * 32 + fq * 8;
                float v[8];
#pragma unroll
                for (int e = 0; e < 4; ++e) { v[e] = acc[ai][bj][m][0][e]; v[4 + e] = acc[ai][bj][m][1][e]; }
                f(row, col, v); } }
}
__device__ __forceinline__ void store8_bf16(bf16_t* p, const float* v) { u32x4 w; w.x = pk2(v[0], v[1]); w.y = pk2(v[2], v[3]); w.z = pk2(v[4], v[5]); w.w = pk2(v[6], v[7]); *(u32x4*)p = w; }

struct EpiStoreBf16 {
    static constexpr bool PERM = true, AFTER_DRAIN = false;
    bf16_t* O; int ldc, pad;
    __device__ __forceinline__ void operator()(const f32x4 (&acc)[2][2][4][2], const pg8::Unit& u, int wr, int wc, int fr, int fq) const {
        epi_for_each(acc, u, wr, wc, fr, fq, [&](int row, int col, float* v) __attribute__((always_inline)) { store8_bf16(O + (size_t)row * ldc + col, v); });
    }
};
struct EpiDft {
    static constexpr bool PERM = true, AFTER_DRAIN = false;
    bf16_t* MIX; int rowbase, L;
    __device__ __forceinline__ void operator()(const f32x4 (&acc)[2][2][4][2], const pg8::Unit& u, int wr, int wc, int fr, int fq) const {
        epi_for_each(acc, u, wr, wc, fr, fq, [&](int row, int col, float* v) __attribute__((always_inline)) { const int b = col >> 8, ch = col & 255; store8_bf16(MIX + (size_t)(rowbase + b * L + row) * DM + 768 + ch, v); });
    }
};
struct EpiResid {
    static constexpr bool PERM = true, AFTER_DRAIN = false;
    const float* xin_lat; const float* xin_ctx; float* xout_lat; float* xout_ctx; const float* mod; int goff, pad;
    __device__ __forceinline__ void operator()(const f32x4 (&acc)[2][2][4][2], const pg8::Unit& u, int wr, int wc, int fr, int fq) const {
        const bool ctx = u.pm >= 64; const float* gv = mod + (size_t)(ctx ? 8 : (u.pm >> 3)) * 6144 + goff;
        const float* xi = ctx ? xin_ctx - (size_t)MLAT * DM : xin_lat; float* xo = ctx ? xout_ctx - (size_t)MLAT * DM : xout_lat;
        epi_for_each(acc, u, wr, wc, fr, fq, [&](int row, int col, float* v) __attribute__((always_inline)) {
            const size_t off = (size_t)row * DM + col; const f32x4 g0 = *(const f32x4*)(gv + col), g1 = *(const f32x4*)(gv + col + 4);
            const f32x4 x0 = *(const f32x4*)(xi + off), x1 = *(const f32x4*)(xi + off + 4); f32x4 o0, o1;
            for (int e = 0; e < 4; ++e) { o0[e] = x0[e] + g0[e] * v[e]; o1[e] = x1[e] + g1[e] * v[4 + e]; }
            *(f32x4*)(xo + off) = o0; *(f32x4*)(xo + off + 4) = o1; });
    }
};
__device__ __forceinline__ float log_forget(float z, float lb) {
    const float e = __expf(-fabsf(z)), r = __builtin_amdgcn_rcpf(1.f + e);
    if (lb <= 0.f) { const float l1p = e < 0.01f ? e * (1.f - e * (0.5f - e * 0.33333333f)) : __logf(1.f + e); return fminf(z, 0.f) - l1p; }
    const float k = (1.f - lb) * (z >= 0.f ? e * r : r);
    return k < 0.01f ? -k * (1.f + k * (0.5f + k * 0.33333333f)) : __logf(1.f - k);
}
struct EpiInProj {
    static constexpr bool PERM = true, AFTER_DRAIN = false;
    bf16_t *QA, *KC, *VT, *QH, *VH, *OG, *UU; float *GF, *GB; const float* rope; const float* lb;
    __device__ __forceinline__ void operator()(const f32x4 (&acc)[2][2][4][2], const pg8::Unit& u, int wr, int wc, int fr, int fq) const {
        const int pn = u.pn; const bool ctx = u.pm >= 64;
        if (pn < 4) {
            epi_for_each(acc, u, wr, wc, fr, fq, [&](int row, int col, float* v) __attribute__((always_inline)) {
                int b, t; if (ctx) { const int rc = row - MLAT; b = rc >> 8; t = rc & 255; } else { b = row >> 11; t = row & 2047; }
                if (!ctx) {
                    const int cl = col & 63, gi = cl >> 5, i0 = cl & 31, j0 = i0 & 15; const bool second = i0 >= 16;
                    const int pos = gi ? (t & 63) : (t >> 6);
                    const float* ct = rope + pos * 16 + j0; const f32x4 c0 = *(const f32x4*)ct, c1 = *(const f32x4*)(ct + 4), s0 = *(const f32x4*)(ct + 1024), s1 = *(const f32x4*)(ct + 1028);
#pragma unroll
                    for (int e = 0; e < 8; ++e) { const float pr = __shfl_xor(v[e], 32); const float cs = e < 4 ? c0[e & 3] : c1[e & 3], sn = e < 4 ? s0[e & 3] : s1[e & 3]; v[e] = second ? v[e] * cs + pr * sn : v[e] * cs - pr * sn; }
                }
                if (pn < 2) {
#pragma unroll
                    for (int e = 0; e < 8; ++e) v[e] *= QSCALE;
                    store8_bf16(QA + (size_t)row * 512 + col, v);
                } else store8_bf16(KC + (size_t)(b * KEYS + (ctx ? t : CTX + t)) * 512 + (col - 512), v);
                asm volatile("" ::: "memory"); });
        } else if (pn < 6) {
            epi_for_each(acc, u, wr, wc, fr, fq, [&](int row, int col, float* v) __attribute__((always_inline)) {
                int b, t; if (ctx) { const int rc = row - MLAT; b = rc >> 8; t = rc & 255; } else { b = row >> 11; t = row & 2047; }
                const int cc = col - 1024, hh = cc >> 7, dv = cc & 127, key = ctx ? t : CTX + t;
                bf16_t* p = VT + ((size_t)((b * 4 + hh) * 128 + dv)) * KEYS + key;
#pragma unroll
                for (int e = 0; e < 8; ++e) p[(size_t)e * KEYS] = f2bf(v[e]);
                asm volatile("" ::: "memory"); });
        } else if (pn == 7 || pn == 8) {
            const float* lbp0 = lb + (pn == 7 ? 0 : 256) - (pn == 7 ? 1792 : 2048); float* G0 = (pn == 7 ? GF : GB) - (pn == 7 ? 1792 : 2048);
            epi_for_each(acc, u, wr, wc, fr, fq, [&](int row, int col, float* v) __attribute__((always_inline)) {
                const float* lbp = lbp0 + col; float* G = G0 + (size_t)row * 256 + col;
                (void)lbp; f32x4 o0, o1;
#pragma unroll
                for (int e = 0; e < 4; ++e) { o0[e] = v[e]; o1[e] = v[4 + e]; }
                *(f32x4*)G = o0; *(f32x4*)(G + 4) = o1;
                asm volatile("" ::: "memory"); });
        } else {
            bf16_t* dst = pn == 6 ? QH : pn == 9 ? VH : pn == 10 ? OG : UU; const int c0 = pn * 256; const bool act = pn == 10;
            epi_for_each(acc, u, wr, wc, fr, fq, [&](int row, int col, float* v) __attribute__((always_inline)) {
                if (act) {
#pragma unroll
                    for (int e = 0; e < 8; ++e) v[e] = silu_f(v[e]);
                }
                store8_bf16(dst + (size_t)row * 256 + (col - c0), v);
                asm volatile("" ::: "memory"); });
        }
    }
};

constexpr int KS_STRIDE = 272, VS_STRIDE = 136;
struct AttnArgs { const bf16_t* QA; const bf16_t* KC; const bf16_t* VT; float* STATS; bf16_t* MIX; const float* lamp; const float* subw; int nlat, nunits; };
template <int PASS> __device__ __forceinline__ void attn_unit(unsigned char* lds, const AttnArgs& A, int unit) {
    const int tid = tid_opaque(), lane = tid & 63, wid = tid >> 6, r32 = lane & 31, hi = lane >> 5;
    int b, h, qrow0, nkeys;
    if (unit < A.nlat) { b = unit >> 5; h = (unit >> 3) & 3; qrow0 = b * SEQ + (unit & 7) * 256; nkeys = KEYS; }
    else { const int uc = unit - A.nlat; b = uc >> 2; h = uc & 3; qrow0 = MLAT + b * CTX; nkeys = CTX; }
    unsigned char* Ks = lds; unsigned char* Vs = lds + 64 * KS_STRIDE;
    const int qrow = qrow0 + wid * 32 + r32;
    bf16x8 qf[2][4];
    { const bf16_t* qp = A.QA + (size_t)qrow * 512 + h * 128 + hi * 8;
#pragma unroll
      for (int c = 0; c < 2; ++c)
#pragma unroll
          for (int s = 0; s < 4; ++s) qf[c][s] = *(const bf16x8*)(qp + c * 64 + s * 16); }
    const float lam = A.lamp[0];
    float m0 = -1e30f, m1 = -1e30f, l0 = 0.f, l1 = 0.f, nM0 = 0.f, nM1 = 0.f;
    f32x16 O[4];
    if (PASS == 2) { nM0 = -A.STATS[(size_t)qrow * 8 + h * 2]; nM1 = -A.STATS[(size_t)qrow * 8 + h * 2 + 1];
#pragma unroll
        for (int d = 0; d < 4; ++d)
#pragma unroll
            for (int r = 0; r < 16; ++r) O[d][r] = 0.f; }
    const bf16_t* kbase = A.KC + (size_t)b * KEYS * 512 + h * 128;
    const bf16_t* vbase = A.VT + (size_t)((b * 4 + h) * 128) * KEYS;
    for (int t0 = 0; t0 < nkeys; t0 += 64) {
        __syncthreads();
#pragma unroll
        for (int i = 0; i < 2; ++i) { const int idx = tid + 512 * i, row = idx >> 4, ch = idx & 15;
            *(u32x4*)(Ks + row * KS_STRIDE + ch * 16) = *(const u32x4*)(kbase + (size_t)(t0 + row) * 512 + ch * 8); }
        if (PASS == 2) {
#pragma unroll
            for (int i = 0; i < 2; ++i) { const int idx = tid + 512 * i, row = idx >> 3, ch = idx & 7;
                const u32x4 w = *(const u32x4*)(vbase + (size_t)row * KEYS + t0 + ch * 8);
                u32x2 a, c2; a.x = w.x; a.y = w.y; c2.x = w.z; c2.y = w.w;
                *(u32x2*)(Vs + row * VS_STRIDE + ch * 16) = a; *(u32x2*)(Vs + row * VS_STRIDE + ch * 16 + 8) = c2; }
        }
        __syncthreads();
#pragma unroll
        for (int kb = 0; kb < 2; ++kb) {
            f32x16 S0, S1;
#pragma unroll
            for (int r = 0; r < 16; ++r) { S0[r] = nM0; S1[r] = nM1; }
            const unsigned char* kp = Ks + (kb * 32 + r32) * KS_STRIDE + hi * 16;
#pragma unroll
            for (int s = 0; s < 4; ++s) {
                const bf16x8 k0 = *(const bf16x8*)(kp + s * 32), k1 = *(const bf16x8*)(kp + 128 + s * 32);
                S0 = __builtin_amdgcn_mfma_f32_32x32x16_bf16(k0, qf[0][s], S0, 0, 0, 0);
                S1 = __builtin_amdgcn_mfma_f32_32x32x16_bf16(k1, qf[1][s], S1, 0, 0, 0);
            }
            if (PASS == 1) {
                float x0 = S0[0], x1 = S1[0];
#pragma unroll
                for (int r = 1; r < 16; ++r) { x0 = fmaxf(x0, S0[r]); x1 = fmaxf(x1, S1[r]); }
                x0 = fmaxf(x0, __shfl_xor(x0, 32)); x1 = fmaxf(x1, __shfl_xor(x1, 32));
                const float n0 = fmaxf(m0, x0), n1 = fmaxf(m1, x1);
                float a0 = 0.f, a1 = 0.f;
#pragma unroll
                for (int r = 0; r < 16; ++r) { a0 += __builtin_amdgcn_exp2f(S0[r] - n0); a1 += __builtin_amdgcn_exp2f(S1[r] - n1); }
                l0 = l0 * __builtin_amdgcn_exp2f(m0 - n0) + a0; l1 = l1 * __builtin_amdgcn_exp2f(m1 - n1) + a1; m0 = n0; m1 = n1;
            } else {
                bf16x8 pa[2];
#pragma unroll
                for (int sp = 0; sp < 2; ++sp) { float a[8];
#pragma unroll
                    for (int j = 0; j < 8; ++j) a[j] = __builtin_amdgcn_exp2f(S0[8 * sp + j]) - lam * __builtin_amdgcn_exp2f(S1[8 * sp + j]);
                    u32x4 w; w.x = pk2(a[0], a[1]); w.y = pk2(a[2], a[3]); w.z = pk2(a[4], a[5]); w.w = pk2(a[6], a[7]);
                    pa[sp] = __builtin_bit_cast(bf16x8, w); }
#pragma unroll
                for (int d = 0; d < 4; ++d)
#pragma unroll
                    for (int sp = 0; sp < 2; ++sp) {
                        const unsigned char* vp = Vs + (d * 32 + r32) * VS_STRIDE + (kb * 32 + 16 * sp + 4 * hi) * 2;
                        const s16x4 lo = *(const s16x4*)vp, hh = *(const s16x4*)(vp + 16);
                        const bf16x8 vf = (bf16x8){lo[0], lo[1], lo[2], lo[3], hh[0], hh[1], hh[2], hh[3]};
                        O[d] = __builtin_amdgcn_mfma_f32_32x32x16_bf16(vf, pa[sp], O[d], 0, 0, 0);
                    }
            }
        }
    }
    if (PASS == 1) {
        l0 += __shfl_xor(l0, 32); l1 += __shfl_xor(l1, 32);
        if (hi == 0) { A.STATS[(size_t)qrow * 8 + h * 2] = m0 + __log2f(l0); A.STATS[(size_t)qrow * 8 + h * 2 + 1] = m1 + __log2f(l1); }
    } else {
        float ss = 0.f;
#pragma unroll
        for (int d = 0; d < 4; ++d)
#pragma unroll
            for (int r = 0; r < 16; ++r) ss += O[d][r] * O[d][r];
        ss += __shfl_xor(ss, 32);
        const float sc = rsqrtf(ss * (1.f / 128.f) + EPS) * A.lamp[2];
        bf16_t* op = A.MIX + (size_t)qrow * DM + h * 128;
#pragma unroll
        for (int d = 0; d < 4; ++d)
#pragma unroll
            for (int g = 0; g < 4; ++g) { const int dv = d * 32 + 8 * g + 4 * hi; const f32x4 w = *(const f32x4*)(A.subw + dv);
                u32x2 pk; pk.x = pk2(O[d][4 * g] * sc * w[0], O[d][4 * g + 1] * sc * w[1]); pk.y = pk2(O[d][4 * g + 2] * sc * w[2], O[d][4 * g + 3] * sc * w[3]);
                *(u32x2*)(op + dv) = pk; }
    }
}

struct P {
    const float *x, *c, *ctx, *c_ctx, *w_ada, *b_ada, *norm1_w, *norm2_w, *w_in, *lam_qk, *subln_w, *lb_param, *hgrn_norm_w, *w_fnet, *w_out, *w_up, *conv_w, *conv_b, *w_down, *final_norm_w;
    float* out; unsigned char* ws;
};
#define WSP(T, off) ((T*)(p.ws + (off)))

__device__ __forceinline__ void small_tables(const P& p) {
    const int tid = tid_opaque(); float* lam_out = WSP(float, WS_LAM); float* lb_out = WSP(float, WS_LB); float* rope = WSP(float, WS_ROPE);
    if (tid < 2) {
        const float* q = p.lam_qk + tid * 256; float s1 = 0.f, s2 = 0.f;
        for (int i = 0; i < 64; ++i) { s1 += q[i] * q[64 + i]; s2 += q[128 + i] * q[192 + i]; }
        const float lam_init = 0.8f - 0.6f * expf(-0.3f * (float)tid);
        lam_out[tid] = expf(s1) - expf(s2) + lam_init; lam_out[2 + tid] = 1.f - lam_init;
    }
    for (int i = tid; i < 512; i += 512) { const float p0 = p.lb_param[i], p1 = p.lb_param[512 + i]; lb_out[i] = 0.f; lb_out[512 + i] = 1.f / (1.f + expf(p0 - p1)); }
    for (int i = tid; i < 1024; i += 512) { const int pos = i >> 4, j = i & 15; const double f = pow(10000.0, -(double)j / 16.0), a = (double)pos * f; rope[i] = (float)cos(a); rope[1024 + i] = (float)sin(a); }
}
__device__ __forceinline__ void adaln_unit(const P& p, unsigned char* lds, int unit) {
    float (*cs)[1024] = (float (*)[1024])lds; float (*red)[9][64] = (float (*)[9][64])(lds + 9 * 1024 * 4);
    const int tid = tid_opaque(), li = unit / 96, nb = unit % 96, n = nb * 64 + (tid & 63), ks = tid >> 6; float* mod = WSP(float, WS_MOD);
    __syncthreads();
    for (int i = tid; i < 9 * 1024; i += 512) { const int r = i >> 10, k = i & 1023; const float v = r < 8 ? p.c[r * 1024 + k] : p.c_ctx[k]; cs[r][k] = silu_f(v); }
    __syncthreads();
    float acc[9];
#pragma unroll
    for (int r = 0; r < 9; ++r) acc[r] = 0.f;
    const float* W = p.w_ada + (size_t)li * 1024 * 6144 + n;
#pragma unroll 4
    for (int k = ks * 128; k < ks * 128 + 128; ++k) { const float w = W[(size_t)k * 6144];
#pragma unroll
        for (int r = 0; r < 9; ++r) acc[r] += cs[r][k] * w; }
#pragma unroll
    for (int r = 0; r < 9; ++r) red[ks][r][tid & 63] = acc[r];
    __syncthreads();
    for (int i = tid; i < 9 * 64; i += 512) { const int r = i >> 6, nn = i & 63; float s = p.b_ada[li * 6144 + nb * 64 + nn];
        for (int q = 0; q < 8; ++q) s += red[q][r][nn];
        mod[((size_t)li * 9 + r) * 6144 + nb * 64 + nn] = s; }
}
__device__ __forceinline__ void transpose_unit(const float* W, int N, bf16_t* WT, int KT, int nt64, int unit, int upperm, unsigned char* lds) {
    float (*t)[65] = (float (*)[65])lds;
    const int tid = tid_opaque(), k0 = (unit / nt64) * 32, n0 = (unit % nt64) * 64;
    __syncthreads();
    { const int tx = tid & 63, ty = tid >> 6; const int np = n0 + tx; int col = np;
      if (upperm) { const int tile = np >> 8, w = np & 255; col = w < 128 ? tile * 128 + w : DFF + tile * 128 + (w - 128); }
#pragma unroll
      for (int i = ty; i < 32; i += 8) t[i][tx] = W[(size_t)(k0 + i) * N + col]; }
    __syncthreads();
    { const int kx = tid & 31, ny = tid >> 5;
#pragma unroll
      for (int i = ny; i < 64; i += 16) WT[(size_t)(n0 + i) * KT + k0 + kx] = f2bf(t[kx][i]); }
}
__device__ __forceinline__ void fold_unit(const P& p, unsigned char* lds, int unit) {
    float (*wf)[256] = (float (*)[256])lds;
    const int tid = tid_opaque(), li = unit >> 7, it = (unit >> 4) & 7, nt = unit & 15, i0 = it * 32, n0 = nt * 64;
    __syncthreads();
    for (int i = tid; i < 32 * 256; i += 512) wf[i >> 8][i & 255] = p.w_fnet[((size_t)li * 256 + i0 + (i >> 8)) * 256 + (i & 255)];
    __syncthreads();
    const int ii = tid >> 4, n4 = (tid & 15) * 4; const float* wo = p.w_out + ((size_t)li * 1024 + 768) * 1024 + n0 + n4;
    f32x4 s = {0.f, 0.f, 0.f, 0.f};
    for (int j = 0; j < 256; ++j) { const f32x4 w = *(const f32x4*)(wo + (size_t)j * 1024); const float a = wf[ii][j]; s[0] += a * w[0]; s[1] += a * w[1]; s[2] += a * w[2]; s[3] += a * w[3]; }
    bf16_t* o = WSP(bf16_t, WS_WOUT) + (size_t)li * DM * DM + (size_t)(n0 + n4) * DM + 768 + i0 + ii;
#pragma unroll
    for (int e = 0; e < 4; ++e) o[(size_t)e * DM] = f2bf(s[e]);
}
__device__ __forceinline__ void dftgen_elem(bf16_t* A, int L, int idx) {
    const int lp = idx / L, kk = idx % L, h = L / 2; const int k = kk <= h ? kk : kk - h;
    const int ph = (int)(((long)k * lp) % L);
    float s, c; sincospif(2.0f * (float)ph / (float)L, &s, &c);
    const float sc = rsqrtf((float)L);
    A[idx] = f2bf(kk <= h ? c * sc : -s * sc);
}
constexpr int TU_WIN = (DM / 32) * (PW / 64), TU_WOUT = (768 / 32) * (DM / 64), TU_WUP = (DM / 32) * (2 * DFF / 64), TU_WDOWN = (DFF / 32) * (DM / 64);
__device__ __forceinline__ void ffn_weight_units(const P& p, unsigned char* lds, int li, int u) {
    if (u < TU_WUP) transpose_unit(p.w_up + (size_t)li * DM * 2 * DFF, 2 * DFF, WSP(bf16_t, WS_WUP), DM, 2 * DFF / 64, u, 1, lds);
    else transpose_unit(p.w_down + (size_t)li * DFF * DM, DM, WSP(bf16_t, WS_WDOWN), DFF, DM / 64, u - TU_WUP, 0, lds);
}
__device__ __forceinline__ void ph_prologue(const P& p, unsigned char* lds) {
    const int G = gridDim.x, bid = blockIdx.x;
    if (bid == G - 1) small_tables(p);
    for (int u = bid; u < 192; u += G) adaln_unit(p, lds, u);
    for (int u = bid; u < 256; u += G) fold_unit(p, lds, u);
    constexpr int NT = 2 * TU_WIN + 2 * TU_WOUT + TU_WUP + TU_WDOWN;
    for (int u = bid; u < NT; u += G) {
        int r = u;
        if (r < 2 * TU_WIN) { const int li = r / TU_WIN; transpose_unit(p.w_in + (size_t)li * DM * PW, PW, WSP(bf16_t, WS_WIN) + (size_t)li * PW * DM, DM, PW / 64, r % TU_WIN, 0, lds); continue; } r -= 2 * TU_WIN;
        if (r < 2 * TU_WOUT) { const int li = r / TU_WOUT; transpose_unit(p.w_out + (size_t)li * DM * DM, DM, WSP(bf16_t, WS_WOUT) + (size_t)li * DM * DM, DM, DM / 64, r % TU_WOUT, 0, lds); continue; } r -= 2 * TU_WOUT;
        ffn_weight_units(p, lds, 0, r);
    }
    for (int i = bid * 512 + tid_opaque(); i < SEQ * SEQ; i += G * 512) dftgen_elem(WSP(bf16_t, WS_DFT), SEQ, i);
    for (int i = bid * 512 + tid_opaque(); i < CTX * CTX; i += G * 512) dftgen_elem(WSP(bf16_t, WS_DFTC), CTX, i);
}

__device__ __forceinline__ void ph_normmod(const float* xlat, const float* xctx, const float* w, const float* mod, bf16_t* H, int shoff, int nrows) {
    const int lane = tid_opaque() & 63, wv = tid_opaque() >> 6;
    for (int row = blockIdx.x * 8 + wv; row < nrows; row += gridDim.x * 8) {
        const float* src = row < MLAT ? xlat + (size_t)row * DM : xctx + (size_t)(row - MLAT) * DM;
        const float* mv = mod + (size_t)(row < MLAT ? (row >> 11) : 8) * 6144 + shoff;
        f32x4 v[4]; float ss = 0.f;
#pragma unroll
        for (int j = 0; j < 4; ++j) { v[j] = *(const f32x4*)(src + (lane + 64 * j) * 4); ss += v[j][0] * v[j][0] + v[j][1] * v[j][1] + v[j][2] * v[j][2] + v[j][3] * v[j][3]; }
        const float rstd = rsqrtf(wave_sum(ss) * (1.f / DM) + EPS);
#pragma unroll
        for (int j = 0; j < 4; ++j) { const int c = (lane + 64 * j) * 4;
            const f32x4 wv4 = *(const f32x4*)(w + c), sh = *(const f32x4*)(mv + c), sc = *(const f32x4*)(mv + 1024 + c);
            float o[4];
#pragma unroll
            for (int e = 0; e < 4; ++e) o[e] = (v[j][e] * rstd * wv4[e]) * (1.f + sc[e]) + sh[e];
            u32x2 pk; pk.x = pk2(o[0], o[1]); pk.y = pk2(o[2], o[3]);
            *(u32x2*)(H + (size_t)row * DM + c) = pk; }
    }
}
__device__ __forceinline__ void ph_finalnorm(float* x, const float* w, int nrows) {
    const int lane = tid_opaque() & 63, wv = tid_opaque() >> 6;
    for (int row = blockIdx.x * 8 + wv; row < nrows; row += gridDim.x * 8) {
        float* src = x + (size_t)row * DM;
        f32x4 v[4]; float ss = 0.f;
#pragma unroll
        for (int j = 0; j < 4; ++j) { v[j] = *(const f32x4*)(src + (lane + 64 * j) * 4); ss += v[j][0] * v[j][0] + v[j][1] * v[j][1] + v[j][2] * v[j][2] + v[j][3] * v[j][3]; }
        const float rstd = rsqrtf(wave_sum(ss) * (1.f / DM) + EPS);
#pragma unroll
        for (int j = 0; j < 4; ++j) { const int c = (lane + 64 * j) * 4; const f32x4 wv4 = *(const f32x4*)(w + c);
            f32x4 o; for (int e = 0; e < 4; ++e) o[e] = v[j][e] * rstd * wv4[e];
            *(f32x4*)(src + c) = o; }
    }
}

template <class Epi> __device__ __forceinline__ void ph_gemm(unsigned char* lds, const pg8::Gemm& g, const Epi& E) {
    pg8::StaticOrder S; S.init(g.M, g.N, (int)gridDim.x, (int)blockIdx.x);
    pg8::gemm_phase<Epi, pg8::StaticOrder, true, true>((LAS unsigned char*)lds, g, S, E);
}

constexpr int LS = 72;
__device__ __forceinline__ int hg_row(int b, int dir, int cs, int i) {
    int q = cs * 64 + i;
    if (q < CTX) return MLAT + b * CTX + (dir ? CTX - 1 - q : q);
    q -= CTX; return b * SEQ + (dir ? SEQ - 1 - q : q);
}
__device__ __forceinline__ f32x4 mm_tile(const bf16_t* A, const bf16_t* Bt, int tm, int tn, int lane, f32x4 acc) {
    const int r = lane & 15, q = lane >> 4;
#pragma unroll
    for (int ks = 0; ks < 2; ++ks) {
        const bf16x8 a = *(const bf16x8*)(A + (tm * 16 + r) * LS + ks * 32 + q * 8), b = *(const bf16x8*)(Bt + (tn * 16 + r) * LS + ks * 32 + q * 8);
        acc = __builtin_amdgcn_mfma_f32_16x16x32_bf16(a, b, acc, 0, 0, 0);
    }
    return acc;
}
struct HgArgs { const bf16_t* QH; const bf16_t* VH; const bf16_t* OG; const float* GF; const float* GB; bf16_t* L; float* DC; bf16_t* MIX; const float* wn; const float* lb; };
__device__ __forceinline__ void ph_hgrn_h1(unsigned char* lds, const HgArgs& A, int nunits) {
    bf16_t* K2t = (bf16_t*)lds; bf16_t* Vt = K2t + 64 * LS; float (*part)[64] = (float (*)[64])(lds + 2 * 64 * LS * 2);
    const int tid = tid_opaque(), lane = tid & 63, wid = tid >> 6, d = tid & 63, p8 = tid >> 6;
    for (int unit = blockIdx.x; unit < nunits; unit += gridDim.x) {
        const int seq = unit / NCH, cs = unit % NCH, dir = seq & 1, bh = seq >> 1, b = bh >> 2, h = bh & 3;
        const float* G = dir ? A.GB : A.GF; const float lbv = A.lb[dir * 256 + h * 64 + d];
        float g[8], c[8]; int rows[8];
#pragma unroll
        for (int e = 0; e < 8; ++e) { rows[e] = hg_row(b, dir, cs, 8 * p8 + e); g[e] = log_forget(G[(size_t)rows[e] * 256 + h * 64 + d], lbv); }
        c[0] = g[0];
#pragma unroll
        for (int e = 1; e < 8; ++e) c[e] = c[e - 1] + g[e];
        __syncthreads();
        part[p8][d] = c[7];
        __syncthreads();
        float off = 0.f, tot = 0.f;
#pragma unroll
        for (int q = 0; q < 8; ++q) { const float x = part[q][d]; tot += x; if (q < p8) off += x; }
#pragma unroll
        for (int e = 0; e < 8; ++e) { const float cc = c[e] + off; const float k = -expm1f(g[e]); K2t[d * LS + 8 * p8 + e] = f2bf(k * __expf(tot - cc)); }
#pragma unroll
        for (int e = 0; e < 8; ++e) Vt[d * LS + 8 * p8 + e] = A.VH[(size_t)rows[e] * 256 + h * 64 + d];
        if (p8 == 0) A.DC[(size_t)unit * 64 + d] = __expf(tot);
        __syncthreads();
        const int tm = wid >> 1; bf16_t* Lp = A.L + (size_t)unit * 4096;
#pragma unroll
        for (int j = 0; j < 2; ++j) { const int tn = 2 * (wid & 1) + j; f32x4 acc = {0.f, 0.f, 0.f, 0.f};
            acc = mm_tile(Vt, K2t, tm, tn, lane, acc);
#pragma unroll
            for (int r = 0; r < 4; ++r) Lp[(tm * 16 + 4 * (lane >> 4) + r) * 64 + tn * 16 + (lane & 15)] = f2bf(acc[r]); }
    }
}
__device__ __forceinline__ void ph_hgrn_scan(bf16_t* L, const float* DC) {
    for (int idx = blockIdx.x * 512 + tid_opaque(); idx < 64 * 4096; idx += gridDim.x * 512) {
        const int seq = idx >> 12, e = idx & 4095, d = e & 63;
        float S = 0.f;
        for (int cs = 0; cs < NCH; ++cs) { const size_t o = ((size_t)seq * NCH + cs) * 4096 + e; const float lv = bf2f(L[o]); L[o] = f2bf(S); S = DC[((size_t)seq * NCH + cs) * 64 + d] * S + lv; }
    }
}
__device__ __forceinline__ void ph_hgrn_h3(unsigned char* lds, const HgArgs& A, int nlat, int nunits) {
    bf16_t* Q1 = (bf16_t*)lds; bf16_t* K1 = Q1 + 64 * LS; bf16_t* Q2 = K1 + 64 * LS; bf16_t* Vt = Q2 + 64 * LS; bf16_t* St = Vt + 64 * LS; bf16_t* Sm = St + 64 * LS;
    float (*part)[64] = (float (*)[64])(lds + 6 * 64 * LS * 2); float (*Ol)[65] = (float (*)[65])(lds + 6 * 64 * LS * 2 + 8 * 64 * 4);
    const int tid = tid_opaque(), lane = tid & 63, wid = tid >> 6, d = tid & 63, p8 = tid >> 6;
    for (int unit = blockIdx.x; unit < nunits; unit += gridDim.x) {
        int b, h, J; bool ctx;
        if (unit < nlat) { ctx = false; b = unit >> 7; h = (unit >> 5) & 3; J = unit & 31; } else { const int uc = unit - nlat; ctx = true; b = uc >> 4; h = (uc >> 2) & 3; J = uc & 3; }
        for (int dir = 0; dir < 2; ++dir) {
            const int cs = ctx ? (dir ? 3 - J : J) : (dir ? 4 + 31 - J : 4 + J);
            const int seq = (b * 4 + h) * 2 + dir; const float* G = dir ? A.GB : A.GF; const float lbv = A.lb[dir * 256 + h * 64 + d];
            float g[8], c[8]; int rows[8];
#pragma unroll
            for (int e = 0; e < 8; ++e) { rows[e] = hg_row(b, dir, cs, 8 * p8 + e); g[e] = log_forget(G[(size_t)rows[e] * 256 + h * 64 + d], lbv); }
            c[0] = g[0];
#pragma unroll
            for (int e = 1; e < 8; ++e) c[e] = c[e - 1] + g[e];
            __syncthreads();
            part[p8][d] = c[7];
            __syncthreads();
            float off = 0.f, R = 0.f;
#pragma unroll
            for (int q = 0; q < 8; ++q) { const float x = part[q][d]; if (q < 4) R += x; if (q < p8) off += x; }
            const bf16_t* Sp = A.L + ((size_t)seq * NCH + cs) * 4096;
#pragma unroll
            for (int e = 0; e < 8; ++e) { const int i = 8 * p8 + e; const float cc = c[e] + off, k = -expm1f(g[e]), q = bf2f(A.QH[(size_t)rows[e] * 256 + h * 64 + d]);
                Q1[i * LS + d] = f2bf(q * __expf(cc - R)); K1[i * LS + d] = f2bf(k * __expf(R - cc)); Q2[i * LS + d] = f2bf(q * __expf(cc));
                Vt[d * LS + i] = A.VH[(size_t)rows[e] * 256 + h * 64 + d];
                St[i * LS + d] = Sp[i * 64 + d]; }
            __syncthreads();
            const int tm = wid >> 1, q4 = lane >> 4, r16 = lane & 15;
#pragma unroll
            for (int j = 0; j < 2; ++j) { const int tn = 2 * (wid & 1) + j; f32x4 acc = {0.f, 0.f, 0.f, 0.f};
                acc = mm_tile(Q1, K1, tm, tn, lane, acc);
#pragma unroll
                for (int r = 0; r < 4; ++r) { const int t = tm * 16 + 4 * q4 + r, s = tn * 16 + r16; Sm[t * LS + s] = f2bf(s <= t ? acc[r] : 0.f); } }
            __syncthreads();
#pragma unroll
            for (int j = 0; j < 2; ++j) { const int tn = 2 * (wid & 1) + j; f32x4 acc = {0.f, 0.f, 0.f, 0.f};
                acc = mm_tile(Sm, Vt, tm, tn, lane, acc);
                acc = mm_tile(Q2, St, tm, tn, lane, acc);
#pragma unroll
                for (int r = 0; r < 4; ++r) { const int t = tm * 16 + 4 * q4 + r, v = tn * 16 + r16;
                    if (dir == 0) Ol[t][v] = acc[r]; else Ol[63 - t][v] += acc[r]; } }
            __syncthreads();
        }
        {
            const int tk = tid >> 3, v0 = (tid & 7) * 8; const int row = ctx ? MLAT + b * CTX + J * 64 + tk : b * SEQ + J * 64 + tk;
            float o[8], ss = 0.f;
#pragma unroll
            for (int e = 0; e < 8; ++e) { o[e] = Ol[tk][v0 + e]; ss += o[e] * o[e]; }
            ss += __shfl_xor(ss, 1); ss += __shfl_xor(ss, 2); ss += __shfl_xor(ss, 4);
            const float rstd = rsqrtf(ss * (1.f / 64.f) + EPS);
            const u32x4 ogw = *(const u32x4*)(A.OG + (size_t)row * 256 + h * 64 + v0);
            const unsigned og[4] = {ogw.x, ogw.y, ogw.z, ogw.w};
#pragma unroll
            for (int e = 0; e < 8; ++e) { const float gt = __uint_as_float((e & 1) ? (og[e >> 1] & 0xffff0000u) : (og[e >> 1] << 16)); o[e] = o[e] * rstd * A.wn[v0 + e] * gt; }
            store8_bf16(A.MIX + (size_t)row * DM + 512 + h * 64 + v0, o);
        }
    }
}

__device__ __forceinline__ void dftprep_unit(unsigned char* lds, const bf16_t* UU, int rowbase, int L, bf16_t* Bt, int unit) {
    float (*F)[256] = (float (*)[256])lds; float (*T)[64] = (float (*)[64])(lds + 32 * 256 * 4);
    const int tid = tid_opaque(), ntile = L / 32, b = unit / ntile, k0 = (unit % ntile) * 32, hL = L / 2;
    __syncthreads();
    if (tid < 64) { float s, c; sincospif((float)tid / 32.f, &s, &c); T[0][tid] = c * 0.125f; T[1][tid] = s * 0.125f; }
    for (int i = tid; i < 32 * 256; i += 512) { const int r = i >> 8, ch = i & 255, kk = k0 + r; const int k = kk <= hL ? kk : kk - hL;
        const float a = bf2f(UU[(size_t)(rowbase + b * L + k) * 256 + ch]);
        float f;
        if (k == 0 || k == hL) f = a; else { const float bb = bf2f(UU[(size_t)(rowbase + b * L + L - k) * 256 + ch]); f = kk <= hL ? a + bb : a - bb; }
        F[r][ch] = f; }
    __syncthreads();
    const int ch = tid >> 1, half = tid & 1, g = ch >> 6, cp = ch & 63;
    float o[16];
#pragma unroll
    for (int i = 0; i < 16; ++i) o[i] = 0.f;
    for (int c = 0; c < 64; ++c) { const int ph = (c * cp) & 63; const float tc = T[0][ph], ts = T[1][ph];
#pragma unroll
        for (int i = 0; i < 16; ++i) { const int r = 16 * half + i; o[i] += F[r][g * 64 + c] * ((k0 + r) <= hL ? tc : ts); } }
    bf16_t* op = Bt + (size_t)(b * 256 + ch) * L + k0 + 16 * half;
    store8_bf16(op, o); store8_bf16(op + 8, o + 8);
}

__device__ __forceinline__ void ph_convgate(const bf16_t* U, int nrows, int seqlen, const float* conv_w, const float* conv_b, bf16_t* G, int grow0) {
    for (int idx = blockIdx.x * 512 + tid_opaque(); idx < nrows * 352; idx += gridDim.x * 512) {
        const int r = idx / 352, j0 = (idx % 352) * 8;
        const int t = r % seqlen; const bool hp = t > 0, hn = t < seqlen - 1;
        const int cg = (j0 >> 7) * 256 + (j0 & 127), cv = cg + 128;
        float og[8];
        const bf16_t* up = U + (size_t)r * 5632;
        u32x4 z; z.x = z.y = z.z = z.w = 0u;
        const u32x4 g1 = *(const u32x4*)(up + cg), v1 = *(const u32x4*)(up + cv);
        const u32x4 g0 = hp ? *(const u32x4*)(up - 5632 + cg) : z, v0 = hp ? *(const u32x4*)(up - 5632 + cv) : z;
        const u32x4 g2 = hn ? *(const u32x4*)(up + 5632 + cg) : z, v2 = hn ? *(const u32x4*)(up + 5632 + cv) : z;
        const unsigned G0[4] = {g0.x, g0.y, g0.z, g0.w}, G1[4] = {g1.x, g1.y, g1.z, g1.w}, G2[4] = {g2.x, g2.y, g2.z, g2.w};
        const unsigned V0[4] = {v0.x, v0.y, v0.z, v0.w}, V1[4] = {v1.x, v1.y, v1.z, v1.w}, V2[4] = {v2.x, v2.y, v2.z, v2.w};
#pragma unroll
        for (int e = 0; e < 8; ++e) {
            const int jg = j0 + e, jv = DFF + j0 + e;
#define UNPK(W) __uint_as_float((e & 1) ? (W[e >> 1] & 0xffff0000u) : (W[e >> 1] << 16))
            const float a = conv_w[jg] * UNPK(G0) + conv_w[2 * DFF + jg] * UNPK(G1) + conv_w[4 * DFF + jg] * UNPK(G2) + conv_b[jg];
            const float c = conv_w[jv] * UNPK(V0) + conv_w[2 * DFF + jv] * UNPK(V1) + conv_w[4 * DFF + jv] * UNPK(V2) + conv_b[jv];
#undef UNPK
            og[e] = silu_f(a) * c;
        }
        store8_bf16(G + (size_t)(grow0 + r) * DFF + j0, og);
    }
}

namespace cg = cooperative_groups;
constexpr int LDS_BYTES = pg8::STAGE_BYTES;
__global__ void __launch_bounds__(512, 2) mega_fwd(P p) {
    extern __shared__ __attribute__((aligned(16))) unsigned char lds[];
    cg::grid_group grid = cg::this_grid();
    float* out = p.out;
    float* MOD = WSP(float, WS_MOD); float* LAM = WSP(float, WS_LAM); float* LB = WSP(float, WS_LB); float* ROPE = WSP(float, WS_ROPE); float* STATS = WSP(float, WS_STATS);
    bf16_t* WIN = WSP(bf16_t, WS_WIN); bf16_t* WOUT = WSP(bf16_t, WS_WOUT); bf16_t* WUP = WSP(bf16_t, WS_WUP); bf16_t* WDOWN = WSP(bf16_t, WS_WDOWN);
    bf16_t* DFT = WSP(bf16_t, WS_DFT); bf16_t* DFTC = WSP(bf16_t, WS_DFTC); float* CTXX = WSP(float, WS_CTXX); bf16_t* H = WSP(bf16_t, WS_H); bf16_t* MIX = H;
    bf16_t* QA = WSP(bf16_t, WS_QA); bf16_t* KC = WSP(bf16_t, WS_KC); bf16_t* VT = WSP(bf16_t, WS_VT); bf16_t* QH = WSP(bf16_t, WS_QH); bf16_t* VH = WSP(bf16_t, WS_VH);
    bf16_t* OG = WSP(bf16_t, WS_OG); bf16_t* UU = WSP(bf16_t, WS_UU); float* GF = WSP(float, WS_GF); float* GB = WSP(float, WS_GB);
    bf16_t* LBUF = WSP(bf16_t, WS_L); float* DC = WSP(float, WS_DC); bf16_t* BT = WSP(bf16_t, WS_BT); bf16_t* BTC = WSP(bf16_t, WS_BTC);
    bf16_t* GBUF = WSP(bf16_t, WS_G); bf16_t* UCH = WSP(bf16_t, WS_UCH);
    const int G = gridDim.x, bid = blockIdx.x;

    ph_prologue(p, lds);
    grid.sync();
    for (int li = 0; li < 2; ++li) {
        const bool last = li == 1; const float* mod = MOD + (size_t)li * 9 * 6144;
        const float* xl = li == 0 ? p.x : (const float*)out; const float* xc = li == 0 ? p.ctx : (const float*)CTXX;
        ph_normmod(xl, xc, p.norm1_w + li * DM, mod, H, 0, MTOT);
        if (li == 1) for (int u = bid; u < TU_WUP + TU_WDOWN; u += G) ffn_weight_units(p, lds, 1, u);
        grid.sync();
        { pg8::Gemm g{H, WIN + (size_t)li * PW * DM, MTOT, PW, DM, 0}; EpiInProj E{QA, KC, VT, QH, VH, OG, UU, GF, GB, ROPE, LB + li * 512}; ph_gemm(lds, g, E); }
        grid.sync();
        const AttnArgs AA{QA, KC, VT, STATS, MIX, LAM + li, p.subln_w + li * 128, 256, last ? 256 : 288};
        const HgArgs HA{QH, VH, OG, GF, GB, LBUF, DC, MIX, p.hgrn_norm_w + li * 64, LB + li * 512};
        for (int u = bid; u < AA.nunits; u += G) attn_unit<1>(lds, AA, u);
        __syncthreads();
        ph_hgrn_h1(lds, HA, 64 * NCH);
        for (int u = bid; u < NB * SEQ / 32; u += G) dftprep_unit(lds, UU, 0, SEQ, BT, u);
        if (!last) for (int u = bid; u < NB * CTX / 32; u += G) dftprep_unit(lds, UU, MLAT, CTX, BTC, u);
        grid.sync();
        for (int u = bid; u < AA.nunits; u += G) attn_unit<2>(lds, AA, u);
        ph_hgrn_scan(LBUF, DC);
        __syncthreads();
        { pg8::Gemm g{DFT, BT, SEQ, NB * 256, SEQ, 0}; EpiDft E{MIX, 0, SEQ}; ph_gemm(lds, g, E); }
        if (!last) { pg8::Gemm g{DFTC, BTC, CTX, NB * 256, CTX, 0}; EpiDft E{MIX, MLAT, CTX}; ph_gemm(lds, g, E); }
        grid.sync();
        ph_hgrn_h3(lds, HA, 1024, last ? 1024 : 1024 + 128);
        grid.sync();
        const int Mff = last ? MLAT : MTOT;
        { pg8::Gemm g{MIX, WOUT + (size_t)li * DM * DM, Mff, DM, DM, 0}; EpiResid E{xl, xc, out, CTXX, mod, 2048, 0}; ph_gemm(lds, g, E); }
        grid.sync();
        ph_normmod(out, CTXX, p.norm2_w + li * DM, mod, H, 3072, Mff);
        grid.sync();
        for (int r0 = 0; r0 < Mff; r0 += 4096) {
            const int nr = (Mff - r0) < 4096 ? (Mff - r0) : 4096;
            { pg8::Gemm g{H + (size_t)r0 * DM, WUP, nr, 2 * DFF, DM, 0}; EpiStoreBf16 E{UCH, 2 * DFF, 0}; ph_gemm(lds, g, E); }
            grid.sync();
            ph_convgate(UCH, nr, r0 < MLAT ? SEQ : CTX, p.conv_w + (size_t)li * 3 * 2 * DFF, p.conv_b + (size_t)li * 2 * DFF, GBUF, r0);
            grid.sync();
        }
        { pg8::Gemm g{GBUF, WDOWN, Mff, DM, DFF, 0}; EpiResid E{out, CTXX, out, CTXX, mod, 5120, 0}; ph_gemm(lds, g, E); }
        grid.sync();
    }
    ph_finalnorm(out, p.final_norm_w, MLAT);
}

extern "C" void kernel_launch(void* const* d_in, const int* in_sizes, int n_in, void* d_out, int out_size, void* d_ws, size_t ws_size, hipStream_t stream) {
    static int grid = 0;
    if (grid == 0) {
        if (n_in != 20 || ws_size < WS_END || out_size != MLAT * DM) { fprintf(stderr, "kernel_launch: unexpected sizes (n_in %d, ws %zu, out %d)\n", n_in, ws_size, out_size); grid = -1; return; }
        int dev = 0, cus = 0, per_cu = 0;
        (void)hipGetDevice(&dev); (void)hipDeviceGetAttribute(&cus, hipDeviceAttributeMultiprocessorCount, dev);
        (void)hipFuncSetAttribute((const void*)mega_fwd, hipFuncAttributeMaxDynamicSharedMemorySize, LDS_BYTES);
        if (hipOccupancyMaxActiveBlocksPerMultiprocessor(&per_cu, (const void*)mega_fwd, 512, LDS_BYTES) != hipSuccess || per_cu < 1) { fprintf(stderr, "kernel_launch: occupancy query failed (%d)\n", per_cu); per_cu = 1; }
        (void)hipGetLastError();
        if (per_cu > 1) per_cu = 1;
        grid = cus * per_cu;
    }
    if (grid < 0) return;
    P p{};
    const float** pp = (const float**)&p;
    for (int i = 0; i < 20; ++i) pp[i] = (const float*)d_in[i];
    p.out = (float*)d_out; p.ws = (unsigned char*)d_ws;
    void* args[] = {&p};
    hipError_t e = hipLaunchCooperativeKernel((const void*)mega_fwd, dim3(grid), dim3(512), args, LDS_BYTES, stream);
    if (e != hipSuccess) fprintf(stderr, "kernel_launch: cooperative launch failed: %s (grid %d)\n", hipGetErrorString(e), grid);
}
```

```cpp
#include <hip/hip_runtime.h>
#include <hip/hip_cooperative_groups.h>
#include <cstdio>
#include <cstdint>
__device__ __forceinline__ int tid_opaque() { int t = threadIdx.x; asm volatile("" : "+v"(t)); return t; }
namespace pg8 {
#define PG8_LAS __attribute__((address_space(3)))
typedef unsigned short bf16_t;
typedef short bf16x8 __attribute__((ext_vector_type(8)));
typedef float f32x4 __attribute__((ext_vector_type(4)));
typedef unsigned u32x4 __attribute__((ext_vector_type(4)));
constexpr int BM = 256, BK = 64, HALF = 128, HTB = HALF * BK * 2  , STAGE_BYTES = 8 * HTB, NXCD = 8, WGM = 8;

__host__ __device__ __forceinline__ int lds_byte(int r, int c) { const int st = (r >> 4) * 2 + (c >> 5), rr = r & 15, cc = c & 31, ob = rr * 64 + cc * 2; return st * 1024 + (ob ^ (((ob >> 9) & 1) << 5)); }
__host__ __device__ __forceinline__ void stage_rc(int b, int& R, int& C) { const int st = b / 1024, sb = b % 1024, swz = sb ^ (((sb >> 9) & 1) << 5); R = (st >> 1) * 16 + swz / 64; C = (st & 1) * 32 + (swz % 64) / 2; }
__host__ __device__ __forceinline__ int perm32(int rho) { const int n = rho >> 4, i = rho & 15; return 8 * (i >> 2) + 4 * n + (i & 3); }

struct Unit { int pm, pn; };
struct Gemm { const bf16_t* A; const bf16_t* Bt; int M, N, K, pad; };

struct StaticOrder {
    int nM, nN, nwg, G, c;
    __host__ __device__ void init(int M, int N, int G_, int c_) { nM = M / BM; nN = N / BM; nwg = nM * nN; G = G_; c = c_; }
    __host__ __device__ bool next(int i, Unit& u) const {
        const long L = (long)i * G + c; if (L >= nwg) return false;
        int wgid = (int)L; { const int q = nwg / NXCD, r = nwg % NXCD, xcd = wgid % NXCD, off = wgid / NXCD; wgid = (xcd < r ? xcd * (q + 1) : r * (q + 1) + (xcd - r) * q) + off; }
        const int nig = WGM * nN, gid = wgid / nig, fm = gid * WGM, gsz = (nM - fm) < WGM ? (nM - fm) : WGM;
        u.pm = fm + ((wgid % nig) % gsz); u.pn = (wgid % nig) / gsz; return true;
    }
    __device__ __forceinline__ void a_ready(const Unit&) const {}
    __device__ __forceinline__ void done(const Unit&) const {}
};

template <class Epi, class Sched, bool ALIGN_EPI = false, bool SP2 = false>
__device__ __forceinline__ void gemm_phase(PG8_LAS unsigned char* lds, const Gemm g, const Sched& S, const Epi& E) {
    const int tid = tid_opaque(), wid = __builtin_amdgcn_readfirstlane(tid >> 6), lane = tid & 63, wr = wid >> 2, wc = wid & 3, fr = lane & 15, fq = lane >> 4;
    const int K = g.K, nt = K / BK;
    unsigned voffA[2], voffB[2];
#pragma unroll
    for (int i = 0; i < 2; ++i) { int R, C; stage_rc(tid * 16 + i * 8192, R, C); const int Rb = Epi::PERM ? ((R & ~31) + perm32(R & 31)) : R;
        voffA[i] = (unsigned)(R * K + C) * 2u; voffB[i] = (unsigned)(Rb * K + C) * 2u; }
    const size_t kstep = (size_t)(BK * 2);
    const size_t hstep = (size_t)HALF * K * 2;
    const size_t tstep = 2 * hstep;
    const unsigned ldsw = (unsigned)wid * 1024u;
    const int aoff = lds_byte(wr * 64 + fr, fq * 8), boff = lds_byte(wc * 32 + fr, fq * 8);
#define PG8_SA(b, h) (((b) * 2 + (h)) * HTB)
#define PG8_SB(b, h) ((4 + (b) * 2 + (h)) * HTB)
#define PG8_STAGE(bufoff, gbase, voff) do { _Pragma("unroll") for (int _i = 0; _i < 2; ++_i) \
        __builtin_amdgcn_global_load_lds((const unsigned*)((const char*)(gbase) + (voff)[_i]), (PG8_LAS unsigned*)(lds + (bufoff) + ldsw + _i * 8192), 16, 0, 0); } while (0)
#define PG8_LDA(dst, b, h) do { _Pragma("unroll") for (int m = 0; m < 4; ++m) _Pragma("unroll") for (int k = 0; k < 2; ++k) dst[m][k] = *(const PG8_LAS bf16x8*)(lds + PG8_SA(b, h) + aoff + m * 2048 + k * 1024); } while (0)
#define PG8_LDB(dst, b, h) do { _Pragma("unroll") for (int n = 0; n < 2; ++n) _Pragma("unroll") for (int k = 0; k < 2; ++k) dst[n][k] = *(const PG8_LAS bf16x8*)(lds + PG8_SB(b, h) + boff + n * 2048 + k * 1024); } while (0)
#define PG8_MMA(ai, bj, At, Bt) do { __builtin_amdgcn_s_setprio(1); _Pragma("unroll") for (int m = 0; m < 4; ++m) _Pragma("unroll") for (int n = 0; n < 2; ++n) _Pragma("unroll") for (int k = 0; k < 2; ++k) \
        acc[ai][bj][m][n] = __builtin_amdgcn_mfma_f32_16x16x32_bf16(Bt[n][k], At[m][k], acc[ai][bj][m][n], 0, 0, 0); __builtin_amdgcn_s_setprio(0); } while (0)
#define PG8_WAIT_V(n) asm volatile("s_waitcnt vmcnt(" #n ")" ::: "memory")
#define PG8_WAIT_L(n) asm volatile("s_waitcnt lgkmcnt(" #n ")" ::: "memory")
#define PG8_BAR __builtin_amdgcn_s_barrier()
#define PG8_SCHED __builtin_amdgcn_sched_barrier(0)
    Unit cur, nxt; int ui = 0;
    if (!S.next(0, cur)) return;
    f32x4 acc[2][2][4][2];
#pragma unroll
    for (int a = 0; a < 2; ++a)
#pragma unroll
        for (int b = 0; b < 2; ++b)
#pragma unroll
            for (int m = 0; m < 4; ++m)
#pragma unroll
                for (int n = 0; n < 2; ++n) acc[a][b][m][n] = (f32x4){0.f, 0.f, 0.f, 0.f};
    bf16x8 At[4][2], B0[2][2], B1[2][2];
    const char* cA = (const char*)g.A + (size_t)cur.pm * tstep; const char* cB = (const char*)g.Bt + (size_t)cur.pn * tstep;
    S.a_ready(cur);
    if constexpr (SP2) {
        PG8_STAGE(PG8_SB(0, 0), cB, voffB); PG8_STAGE(PG8_SB(0, 1), cB + hstep, voffB); PG8_STAGE(PG8_SA(0, 0), cA, voffA); PG8_STAGE(PG8_SA(0, 1), cA + hstep, voffA);
        if (wr == 1) PG8_BAR;
        PG8_WAIT_V(2); PG8_BAR;
        PG8_STAGE(PG8_SB(1, 0), cB + kstep, voffB); PG8_STAGE(PG8_SA(1, 0), cA + kstep, voffA); PG8_STAGE(PG8_SB(1, 1), cB + hstep + kstep, voffB);
        PG8_WAIT_V(6); PG8_BAR;
    } else {
        PG8_STAGE(PG8_SB(0, 0), cB, voffB); PG8_STAGE(PG8_SA(0, 0), cA, voffA); PG8_STAGE(PG8_SB(0, 1), cB + hstep, voffB); PG8_STAGE(PG8_SA(0, 1), cA + hstep, voffA);
        if (wr == 1) PG8_BAR;
        PG8_WAIT_V(4); PG8_BAR;
        PG8_STAGE(PG8_SB(1, 0), cB + kstep, voffB); PG8_STAGE(PG8_SA(1, 0), cA + kstep, voffA); PG8_STAGE(PG8_SB(1, 1), cB + hstep + kstep, voffB);
        PG8_WAIT_V(6); PG8_BAR;
    }
    for (;;) {
        const bool has_next = S.next(ui + 1, nxt);
        const char* nA = has_next ? (const char*)g.A + (size_t)nxt.pm * tstep : cA; const char* nB = has_next ? (const char*)g.Bt + (size_t)nxt.pn * tstep : cB;
        for (int t = 0; t < nt; t += 2) {
            const bool last = (t == nt - 2);
            const char* a1 = cA + (size_t)(t + 1) * kstep;
            const char* a2 = last ? nA : cA + (size_t)(t + 2) * kstep; const char* b2 = last ? nB : cB + (size_t)(t + 2) * kstep;
            const char* a3 = a2 + kstep; const char* b3 = b2 + kstep;
            if (last && has_next) S.a_ready(nxt);
            if constexpr (SP2) {
            PG8_LDB(B0, 0, 0); PG8_LDB(B1, 0, 1); PG8_SCHED; PG8_LDA(At, 0, 0); PG8_STAGE(PG8_SA(1, 1), a1 + hstep, voffA);
            PG8_WAIT_V(8); PG8_WAIT_L(0); PG8_BAR; PG8_MMA(0, 0, At, B0); PG8_MMA(0, 1, At, B1); PG8_BAR; PG8_SCHED;
            PG8_LDA(At, 0, 1); PG8_STAGE(PG8_SB(0, 0), b2, voffB); PG8_STAGE(PG8_SB(0, 1), b2 + hstep, voffB); PG8_STAGE(PG8_SA(0, 0), a2, voffA);
            PG8_WAIT_V(8); PG8_WAIT_L(0); PG8_BAR; PG8_MMA(1, 0, At, B0); PG8_MMA(1, 1, At, B1); PG8_BAR; PG8_SCHED;
            PG8_LDB(B0, 1, 0); PG8_LDB(B1, 1, 1); PG8_SCHED; PG8_LDA(At, 1, 0); PG8_STAGE(PG8_SA(0, 1), a2 + hstep, voffA);
            PG8_WAIT_V(8); PG8_WAIT_L(0); PG8_BAR; PG8_MMA(0, 0, At, B0); PG8_MMA(0, 1, At, B1); PG8_BAR; PG8_SCHED;
            PG8_LDA(At, 1, 1); PG8_STAGE(PG8_SB(1, 0), b3, voffB); PG8_STAGE(PG8_SB(1, 1), b3 + hstep, voffB); PG8_STAGE(PG8_SA(1, 0), a3, voffA);
            PG8_WAIT_V(8); PG8_WAIT_L(0); PG8_BAR; PG8_MMA(1, 0, At, B0); PG8_MMA(1, 1, At, B1); PG8_BAR; PG8_SCHED;
            } else {
            PG8_LDB(B0, 0, 0); PG8_SCHED; PG8_LDA(At, 0, 0); PG8_STAGE(PG8_SA(1, 1), a1 + hstep, voffA);
            PG8_WAIT_L(8); PG8_BAR; PG8_WAIT_L(0); PG8_MMA(0, 0, At, B0); PG8_BAR; PG8_SCHED;
            PG8_LDB(B1, 0, 1); PG8_STAGE(PG8_SB(0, 0), b2, voffB);
            PG8_BAR; PG8_WAIT_L(0); PG8_MMA(0, 1, At, B1); PG8_BAR;
            PG8_LDA(At, 0, 1); PG8_STAGE(PG8_SA(0, 0), a2, voffA);
            PG8_BAR; PG8_WAIT_L(0); PG8_MMA(1, 0, At, B0); PG8_BAR; PG8_SCHED;
            PG8_STAGE(PG8_SB(0, 1), b2 + hstep, voffB);
            PG8_WAIT_V(6); PG8_BAR; PG8_MMA(1, 1, At, B1); PG8_BAR;
            PG8_LDB(B0, 1, 0); PG8_SCHED; PG8_LDA(At, 1, 0); PG8_STAGE(PG8_SA(0, 1), a2 + hstep, voffA);
            PG8_WAIT_L(8); PG8_BAR; PG8_WAIT_L(0); PG8_MMA(0, 0, At, B0); PG8_BAR; PG8_SCHED;
            PG8_LDB(B1, 1, 1); PG8_STAGE(PG8_SB(1, 0), b3, voffB);
            PG8_BAR; PG8_WAIT_L(0); PG8_MMA(0, 1, At, B1); PG8_BAR;
            PG8_LDA(At, 1, 1); PG8_STAGE(PG8_SA(1, 0), a3, voffA);
            PG8_BAR; PG8_WAIT_L(0); PG8_MMA(1, 0, At, B0); PG8_BAR; PG8_SCHED;
            PG8_STAGE(PG8_SB(1, 1), b3 + hstep, voffB);
            PG8_WAIT_V(6); PG8_BAR; PG8_MMA(1, 1, At, B1); PG8_BAR;
            }
        }
        if constexpr (ALIGN_EPI) { if (wr == 0) PG8_BAR; }
        if constexpr (!Epi::AFTER_DRAIN) { E(acc, cur, wr, wc, fr, fq); S.done(cur); }
        if (!has_next) break;
#pragma unroll
        for (int a = 0; a < 2; ++a)
#pragma unroll
            for (int b = 0; b < 2; ++b)
#pragma unroll
                for (int m = 0; m < 4; ++m)
#pragma unroll
                    for (int n = 0; n < 2; ++n) acc[a][b][m][n] = (f32x4){0.f, 0.f, 0.f, 0.f};
        cur = nxt; cA = nA; cB = nB; ++ui;
        if constexpr (ALIGN_EPI) { if (wr == 1) PG8_BAR; }
    }
    PG8_WAIT_V(0);
    if constexpr (!ALIGN_EPI) { if (wr == 0) PG8_BAR; }
    PG8_BAR;
    if constexpr (Epi::AFTER_DRAIN) { E.fused(acc, cur, wr, wc, fr, fq, lds, wid, lane); S.done(cur); }
#undef PG8_SA
#undef PG8_SB
#undef PG8_STAGE
#undef PG8_LDA
#undef PG8_LDB
#undef PG8_MMA
#undef PG8_WAIT_V
#undef PG8_WAIT_L
#undef PG8_BAR
#undef PG8_SCHED
}
}

using pg8::bf16_t; using pg8::bf16x8; using pg8::f32x4;
typedef float f32x16 __attribute__((ext_vector_type(16)));
typedef short s16x4 __attribute__((ext_vector_type(4)));
typedef unsigned u32x4 __attribute__((ext_vector_type(4)));
typedef unsigned u32x2 __attribute__((ext_vector_type(2)));
#define LAS __attribute__((address_space(3)))

constexpr int DM = 1024, NB = 8, SEQ = 2048, CTX = 256, MLAT = NB * SEQ, MCTX = NB * CTX, MTOT = MLAT + MCTX;
constexpr int PW = 3072, DFF = 2816, KEYS = SEQ + CTX, NCH = 36  ;
constexpr float EPS = 1e-6f;
constexpr float QSCALE = 0.125f * 1.4426950408889634f;

constexpr size_t MiB = 1u << 20;
constexpr size_t WS_CTL = 0;
constexpr size_t WS_MOD = 64 * 1024;
constexpr size_t WS_LAM = 512 * 1024;
constexpr size_t WS_LB = WS_LAM + 256;
constexpr size_t WS_ROPE = WS_LB + 4096;
constexpr size_t WS_STATS = 1 * MiB;
constexpr size_t WS_WIN = 4 * MiB;
constexpr size_t WS_WOUT = 16 * MiB;
constexpr size_t WS_WUP = 21 * MiB;
constexpr size_t WS_WDOWN = 32 * MiB;
constexpr size_t WS_DFT = 38 * MiB;
constexpr size_t WS_DFTC = 46 * MiB;
constexpr size_t WS_CTXX = 47 * MiB;
constexpr size_t WS_H = 55 * MiB;
constexpr size_t WS_QA = 91 * MiB;
constexpr size_t WS_KC = 109 * MiB;
constexpr size_t WS_VT = 127 * MiB;
constexpr size_t WS_QH = 145 * MiB;
constexpr size_t WS_VH = 154 * MiB;
constexpr size_t WS_OG = 163 * MiB;
constexpr size_t WS_UU = 172 * MiB;
constexpr size_t WS_GF = 181 * MiB;
constexpr size_t WS_GB = 199 * MiB;
constexpr size_t WS_L = 217 * MiB;
constexpr size_t WS_DC = 235 * MiB;
constexpr size_t WS_BT = 236 * MiB;
constexpr size_t WS_BTC = 244 * MiB;
constexpr size_t WS_FOLD = 245 * MiB;
constexpr size_t WS_G = 91 * MiB;
constexpr size_t WS_UCH = 190 * MiB;
constexpr size_t WS_END = 248 * MiB;

__device__ __forceinline__ bf16_t f2bf(float f) { unsigned u = __float_as_uint(f); return (bf16_t)((u + 0x7fffu + ((u >> 16) & 1u)) >> 16); }
__device__ __forceinline__ float bf2f(bf16_t h) { return __uint_as_float(((unsigned)h) << 16); }
__device__ __forceinline__ unsigned pk2(float lo, float hi) { return (unsigned)f2bf(lo) | ((unsigned)f2bf(hi) << 16); }
__device__ __forceinline__ float silu_f(float v) { return v / (1.f + __expf(-v)); }
__device__ __forceinline__ float wave_sum(float v) {
#pragma unroll
    for (int o = 1; o < 64; o <<= 1) v += __shfl_xor(v, o);
    return v;
}

template <class F> __device__ __forceinline__ void epi_for_each(const f32x4 (&acc)[2][2][4][2], const pg8::Unit& u, int wr, int wc, int fr, int fq, F f) {
#pragma unroll
    for (int ai = 0; ai < 2; ++ai)
#pragma unroll
        for (int m = 0; m < 4; ++m) { const int row = u.pm * 256 + ai * 128 + wr * 64 + m * 16 + fr;
#pragma unroll
            for (int bj = 0; bj < 2; ++bj) { const int col = u.pn * 256 + bj * 128 + wc * 32 + fq * 8;
                float v[8];
#pragma unroll
                for (int e = 0; e < 4; ++e) { v[e] = acc[ai][bj][m][0][e]; v[4 + e] = acc[ai][bj][m][1][e]; }
                f(row, col, v); } }
}
__device__ __forceinline__ void store8_bf16(bf16_t* p, const float* v) { u32x4 w; w.x = pk2(v[0], v[1]); w.y = pk2(v[2], v[3]); w.z = pk2(v[4], v[5]); w.w = pk2(v[6], v[7]); *(u32x4*)p = w; }

struct EpiStoreBf16 {
    static constexpr bool PERM = true, AFTER_DRAIN = false;
    bf16_t* O; int ldc, pad;
    __device__ __forceinline__ void operator()(const f32x4 (&acc)[2][2][4][2], const pg8::Unit& u, int wr, int wc, int fr, int fq) const {
        epi_for_each(acc, u, wr, wc, fr, fq, [&](int row, int col, float* v) __attribute__((always_inline)) { store8_bf16(O + (size_t)row * ldc + col, v); });
    }
};
struct EpiDft {
    static constexpr bool PERM = true, AFTER_DRAIN = false;
    bf16_t* MIX; int rowbase, L;
    __device__ __forceinline__ void operator()(const f32x4 (&acc)[2][2][4][2], const pg8::Unit& u, int wr, int wc, int fr, int fq) const {
        epi_for_each(acc, u, wr, wc, fr, fq, [&](int row, int col, float* v) __attribute__((always_inline)) { const int b = col >> 8, ch = col & 255; store8_bf16(MIX + (size_t)(rowbase + b * L + row) * DM + 768 + ch, v); });
    }
};
struct EpiResid {
    static constexpr bool PERM = true, AFTER_DRAIN = false;
    const float* xin_lat; const float* xin_ctx; float* xout_lat; float* xout_ctx; const float* mod; int goff, pad;
    __device__ __forceinline__ void operator()(const f32x4 (&acc)[2][2][4][2], const pg8::Unit& u, int wr, int wc, int fr, int fq) const {
        const bool ctx = u.pm >= 64; const float* gv = mod + (size_t)(ctx ? 8 : (u.pm >> 3)) * 6144 + goff;
        const float* xi = ctx ? xin_ctx - (size_t)MLAT * DM : xin_lat; float* xo = ctx ? xout_ctx - (size_t)MLAT * DM : xout_lat;
        epi_for_each(acc, u, wr, wc, fr, fq, [&](int row, int col, float* v) __attribute__((always_inline)) {
            const size_t off = (size_t)row * DM + col; const f32x4 g0 = *(const f32x4*)(gv + col), g1 = *(const f32x4*)(gv + col + 4);
            const f32x4 x0 = *(const f32x4*)(xi + off), x1 = *(const f32x4*)(xi + off + 4); f32x4 o0, o1;
            for (int e = 0; e < 4; ++e) { o0[e] = x0[e] + g0[e] * v[e]; o1[e] = x1[e] + g1[e] * v[4 + e]; }
            *(f32x4*)(xo + off) = o0; *(f32x4*)(xo + off + 4) = o1; });
    }
};
__device__ __forceinline__ float log_forget(float z, float lb) {
    const float e = __expf(-fabsf(z)), r = __builtin_amdgcn_rcpf(1.f + e);
    if (lb <= 0.f) { const float l1p = e < 0.01f ? e * (1.f - e * (0.5f - e * 0.33333333f)) : __logf(1.f + e); return fminf(z, 0.f) - l1p; }
    const float k = (1.f - lb) * (z >= 0.f ? e * r : r);
    return k < 0.01f ? -k * (1.f + k * (0.5f + k * 0.33333333f)) : __logf(1.f - k);
}
struct EpiInProj {
    static constexpr bool PERM = true, AFTER_DRAIN = false;
    bf16_t *QA, *KC, *VT, *QH, *VH, *OG, *UU; float *GF, *GB; const float* rope; const float* lb;
    __device__ __forceinline__ void operator()(const f32x4 (&acc)[2][2][4][2], const pg8::Unit& u, int wr, int wc, int fr, int fq) const {
        const int pn = u.pn; const bool ctx = u.pm >= 64;
        if (pn < 4) {
            epi_for_each(acc, u, wr, wc, fr, fq, [&](int row, int col, float* v) __attribute__((always_inline)) {
                int b, t; if (ctx) { const int rc = row - MLAT; b = rc >> 8; t = rc & 255; } else { b = row >> 11; t = row & 2047; }
                if (!ctx) {
                    const int cl = col & 63, gi = cl >> 5, i0 = cl & 31, j0 = i0 & 15; const bool second = i0 >= 16;
                    const int pos = gi ? (t & 63) : (t >> 6);
                    const float* ct = rope + pos * 16 + j0; const f32x4 c0 = *(const f32x4*)ct, c1 = *(const f32x4*)(ct + 4), s0 = *(const f32x4*)(ct + 1024), s1 = *(const f32x4*)(ct + 1028);
#pragma unroll
                    for (int e = 0; e < 8; ++e) { const float pr = __shfl_xor(v[e], 32); const float cs = e < 4 ? c0[e & 3] : c1[e & 3], sn = e < 4 ? s0[e & 3] : s1[e & 3]; v[e] = second ? v[e] * cs + pr * sn : v[e] * cs - pr * sn; }
                }
                if (pn < 2) {
#pragma unroll
                    for (int e = 0; e < 8; ++e) v[e] *= QSCALE;
                    store8_bf16(QA + (size_t)row * 512 + col, v);
                } else store8_bf16(KC + (size_t)(b * KEYS + (ctx ? t : CTX + t)) * 512 + (col - 512), v);
                asm volatile("" ::: "memory"); });
        } else if (pn < 6) {
            epi_for_each(acc, u, wr, wc, fr, fq, [&](int row, int col, float* v) __attribute__((always_inline)) {
                int b, t; if (ctx) { const int rc = row - MLAT; b = rc >> 8; t = rc & 255; } else { b = row >> 11; t = row & 2047; }
                const int cc = col - 1024, hh = cc >> 7, dv = cc & 127, key = ctx ? t : CTX + t;
                bf16_t* p = VT + ((size_t)((b * 4 + hh) * 128 + dv)) * KEYS + key;
#pragma unroll
                for (int e = 0; e < 8; ++e) p[(size_t)e * KEYS] = f2bf(v[e]);
                asm volatile("" ::: "memory"); });
        } else if (pn == 7 || pn == 8) {
            const float* lbp0 = lb + (pn == 7 ? 0 : 256) - (pn == 7 ? 1792 : 2048); float* G0 = (pn == 7 ? GF : GB) - (pn == 7 ? 1792 : 2048);
            epi_for_each(acc, u, wr, wc, fr, fq, [&](int row, int col, float* v) __attribute__((always_inline)) {
                const float* lbp = lbp0 + col; float* G = G0 + (size_t)row * 256 + col;
                (void)lbp; f32x4 o0, o1;
#pragma unroll
                for (int e = 0; e < 4; ++e) { o0[e] = v[e]; o1[e] = v[4 + e]; }
                *(f32x4*)G = o0; *(f32x4*)(G + 4) = o1;
                asm volatile("" ::: "memory"); });
        } else {
            bf16_t* dst = pn == 6 ? QH : pn == 9 ? VH : pn == 10 ? OG : UU; const int c0 = pn * 256; const bool act = pn == 10;
            epi_for_each(acc, u, wr, wc, fr, fq, [&](int row, int col, float* v) __attribute__((always_inline)) {
                if (act) {
#pragma unroll
                    for (int e = 0; e < 8; ++e) v[e] = silu_f(v[e]);
                }
                store8_bf16(dst + (size_t)row * 256 + (col - c0), v);
                asm volatile("" ::: "memory"); });
        }
    }
};

constexpr int KS_STRIDE = 272, VS_STRIDE = 136;
struct AttnArgs { const bf16_t* QA; const bf16_t* KC; const bf16_t* VT; float* STATS; bf16_t* MIX; const float* lamp; const float* subw; int nlat, nunits; };
template <int PASS> __device__ __forceinline__ void attn_unit(unsigned char* lds, const AttnArgs& A, int unit) {
    const int tid = tid_opaque(), lane = tid & 63, wid = tid >> 6, r32 = lane & 31, hi = lane >> 5;
    int b, h, qrow0, nkeys;
    if (unit < A.nlat) { b = unit >> 5; h = (unit >> 3) & 3; qrow0 = b * SEQ + (unit & 7) * 256; nkeys = KEYS; }
    else { const int uc = unit - A.nlat; b = uc >> 2; h = uc & 3; qrow0 = MLAT + b * CTX; nkeys = CTX; }
    unsigned char* Ks = lds; unsigned char* Vs = lds + 64 * KS_STRIDE;
    const int qrow = qrow0 + wid * 32 + r32;
    bf16x8 qf[2][4];
    { const bf16_t* qp = A.QA + (size_t)qrow * 512 + h * 128 + hi * 8;
#pragma unroll
      for (int c = 0; c < 2; ++c)
#pragma unroll
          for (int s = 0; s < 4; ++s) qf[c][s] = *(const bf16x8*)(qp + c * 64 + s * 16); }
    const float lam = A.lamp[0];
    float m0 = -1e30f, m1 = -1e30f, l0 = 0.f, l1 = 0.f, nM0 = 0.f, nM1 = 0.f;
    f32x16 O[4];
    if (PASS == 2) { nM0 = -A.STATS[(size_t)qrow * 8 + h * 2]; nM1 = -A.STATS[(size_t)qrow * 8 + h * 2 + 1];
#pragma unroll
        for (int d = 0; d < 4; ++d)
#pragma unroll
            for (int r = 0; r < 16; ++r) O[d][r] = 0.f; }
    const bf16_t* kbase = A.KC + (size_t)b * KEYS * 512 + h * 128;
    const bf16_t* vbase = A.VT + (size_t)((b * 4 + h) * 128) * KEYS;
    for (int t0 = 0; t0 < nkeys; t0 += 64) {
        __syncthreads();
#pragma unroll
        for (int i = 0; i < 2; ++i) { const int idx = tid + 512 * i, row = idx >> 4, ch = idx & 15;
            *(u32x4*)(Ks + row * KS_STRIDE + ch * 16) = *(const u32x4*)(kbase + (size_t)(t0 + row) * 512 + ch * 8); }
        if (PASS == 2) {
#pragma unroll
            for (int i = 0; i < 2; ++i) { const int idx = tid + 512 * i, row = idx >> 3, ch = idx & 7;
                const u32x4 w = *(const u32x4*)(vbase + (size_t)row * KEYS + t0 + ch * 8);
                u32x2 a, c2; a.x = w.x; a.y = w.y; c2.x = w.z; c2.y = w.w;
                *(u32x2*)(Vs + row * VS_STRIDE + ch * 16) = a; *(u32x2*)(Vs + row * VS_STRIDE + ch * 16 + 8) = c2; }
        }
        __syncthreads();
#pragma unroll
        for (int kb = 0; kb < 2; ++kb) {
            f32x16 S0, S1;
#pragma unroll
            for (int r = 0; r < 16; ++r) { S0[r] = nM0; S1[r] = nM1; }
            const unsigned char* kp = Ks + (kb * 32 + r32) * KS_STRIDE + hi * 16;
#pragma unroll
            for (int s = 0; s < 4; ++s) {
                const bf16x8 k0 = *(const bf16x8*)(kp + s * 32), k1 = *(const bf16x8*)(kp + 128 + s * 32);
                S0 = __builtin_amdgcn_mfma_f32_32x32x16_bf16(k0, qf[0][s], S0, 0, 0, 0);
                S1 = __builtin_amdgcn_mfma_f32_32x32x16_bf16(k1, qf[1][s], S1, 0, 0, 0);
            }
            if (PASS == 1) {
                float x0 = S0[0], x1 = S1[0];
#pragma unroll
                for (int r = 1; r < 16; ++r) { x0 = fmaxf(x0, S0[r]); x1 = fmaxf(x1, S1[r]); }
                x0 = fmaxf(x0, __shfl_xor(x0, 32)); x1 = fmaxf(x1, __shfl_xor(x1, 32));
                const float n0 = fmaxf(m0, x0), n1 = fmaxf(m1, x1);
                float a0 = 0.f, a1 = 0.f;
#pragma unroll
                for (int r = 0; r < 16; ++r) { a0 += __builtin_amdgcn_exp2f(S0[r] - n0); a1 += __builtin_amdgcn_exp2f(S1[r] - n1); }
                l0 = l0 * __builtin_amdgcn_exp2f(m0 - n0) + a0; l1 = l1 * __builtin_amdgcn_exp2f(m1 - n1) + a1; m0 = n0; m1 = n1;
            } else {
                bf16x8 pa[2];
#pragma unroll
                for (int sp = 0; sp < 2; ++sp) { float a[8];
#pragma unroll
                    for (int j = 0; j < 8; ++j) a[j] = __builtin_amdgcn_exp2f(S0[8 * sp + j]) - lam * __builtin_amdgcn_exp2f(S1[8 * sp + j]);
                    u32x4 w; w.x = pk2(a[0], a[1]); w.y = pk2(a[2], a[3]); w.z = pk2(a[4], a[5]); w.w = pk2(a[6], a[7]);
                    pa[sp] = __builtin_bit_cast(bf16x8, w); }
#pragma unroll
                for (int d = 0; d < 4; ++d)
#pragma unroll
                    for (int sp = 0; sp < 2; ++sp) {
                        const unsigned char* vp = Vs + (d * 32 + r32) * VS_STRIDE + (kb * 32 + 16 * sp + 4 * hi) * 2;
                        const s16x4 lo = *(const s16x4*)vp, hh = *(const s16x4*)(vp + 16);
                        const bf16x8 vf = (bf16x8){lo[0], lo[1], lo[2], lo[3], hh[0], hh[1], hh[2], hh[3]};
                        O[d] = __builtin_amdgcn_mfma_f32_32x32x16_bf16(vf, pa[sp], O[d], 0, 0, 0);
                    }
            }
        }
    }
    if (PASS == 1) {
        l0 += __shfl_xor(l0, 32); l1 += __shfl_xor(l1, 32);
        if (hi == 0) { A.STATS[(size_t)qrow * 8 + h * 2] = m0 + __log2f(l0); A.STATS[(size_t)qrow * 8 + h * 2 + 1] = m1 + __log2f(l1); }
    } else {
        float ss = 0.f;
#pragma unroll
        for (int d = 0; d < 4; ++d)
#pragma unroll
            for (int r = 0; r < 16; ++r) ss += O[d][r] * O[d][r];
        ss += __shfl_xor(ss, 32);
        const float sc = rsqrtf(ss * (1.f / 128.f) + EPS) * A.lamp[2];
        bf16_t* op = A.MIX + (size_t)qrow * DM + h * 128;
#pragma unroll
        for (int d = 0; d < 4; ++d)
#pragma unroll
            for (int g = 0; g < 4; ++g) { const int dv = d * 32 + 8 * g + 4 * hi; const f32x4 w = *(const f32x4*)(A.subw + dv);
                u32x2 pk; pk.x = pk2(O[d][4 * g] * sc * w[0], O[d][4 * g + 1] * sc * w[1]); pk.y = pk2(O[d][4 * g + 2] * sc * w[2], O[d][4 * g + 3] * sc * w[3]);
                *(u32x2*)(op + dv) = pk; }
    }
}

struct P {
    const float *x, *c, *ctx, *c_ctx, *w_ada, *b_ada, *norm1_w, *norm2_w, *w_in, *lam_qk, *subln_w, *lb_param, *hgrn_norm_w, *w_fnet, *w_out, *w_up, *conv_w, *conv_b, *w_down, *final_norm_w;
    float* out; unsigned char* ws;
};
#define WSP(T, off) ((T*)(p.ws + (off)))

__device__ __forceinline__ void small_tables(const P& p) {
    const int tid = tid_opaque(); float* lam_out = WSP(float, WS_LAM); float* lb_out = WSP(float, WS_LB); float* rope = WSP(float, WS_ROPE);
    if (tid < 2) {
        const float* q = p.lam_qk + tid * 256; float s1 = 0.f, s2 = 0.f;
        for (int i = 0; i < 64; ++i) { s1 += q[i] * q[64 + i]; s2 += q[128 + i] * q[192 + i]; }
        const float lam_init = 0.8f - 0.6f * expf(-0.3f * (float)tid);
        lam_out[tid] = expf(s1) - expf(s2) + lam_init; lam_out[2 + tid] = 1.f - lam_init;
    }
    for (int i = tid; i < 512; i += 512) { const float p0 = p.lb_param[i], p1 = p.lb_param[512 + i]; lb_out[i] = 0.f; lb_out[512 + i] = 1.f / (1.f + expf(p0 - p1)); }
    for (int i = tid; i < 1024; i += 512) { const int pos = i >> 4, j = i & 15; const double f = pow(10000.0, -(double)j / 16.0), a = (double)pos * f; rope[i] = (float)cos(a); rope[1024 + i] = (float)sin(a); }
}
__device__ __forceinline__ void adaln_unit(const P& p, unsigned char* lds, int unit) {
    float (*cs)[1024] = (float (*)[1024])lds; float (*red)[9][64] = (float (*)[9][64])(lds + 9 * 1024 * 4);
    const int tid = tid_opaque(), li = unit / 96, nb = unit % 96, n = nb * 64 + (tid & 63), ks = tid >> 6; float* mod = WSP(float, WS_MOD);
    __syncthreads();
    for (int i = tid; i < 9 * 1024; i += 512) { const int r = i >> 10, k = i & 1023; const float v = r < 8 ? p.c[r * 1024 + k] : p.c_ctx[k]; cs[r][k] = silu_f(v); }
    __syncthreads();
    float acc[9];
#pragma unroll
    for (int r = 0; r < 9; ++r) acc[r] = 0.f;
    const float* W = p.w_ada + (size_t)li * 1024 * 6144 + n;
#pragma unroll 4
    for (int k = ks * 128; k < ks * 128 + 128; ++k) { const float w = W[(size_t)k * 6144];
#pragma unroll
        for (int r = 0; r < 9; ++r) acc[r] += cs[r][k] * w; }
#pragma unroll
    for (int r = 0; r < 9; ++r) red[ks][r][tid & 63] = acc[r];
    __syncthreads();
    for (int i = tid; i < 9 * 64; i += 512) { const int r = i >> 6, nn = i & 63; float s = p.b_ada[li * 6144 + nb * 64 + nn];
        for (int q = 0; q < 8; ++q) s += red[q][r][nn];
        mod[((size_t)li * 9 + r) * 6144 + nb * 64 + nn] = s; }
}
__device__ __forceinline__ void transpose_unit(const float* W, int N, bf16_t* WT, int KT, int nt64, int unit, int upperm, unsigned char* lds) {
    float (*t)[65] = (float (*)[65])lds;
    const int tid = tid_opaque(), k0 = (unit / nt64) * 32, n0 = (unit % nt64) * 64;
    __syncthreads();
    { const int tx = tid & 63, ty = tid >> 6; const int np = n0 + tx; int col = np;
      if (upperm) { const int tile = np >> 8, w = np & 255; col = w < 128 ? tile * 128 + w : DFF + tile * 128 + (w - 128); }
#pragma unroll
      for (int i = ty; i < 32; i += 8) t[i][tx] = W[(size_t)(k0 + i) * N + col]; }
    __syncthreads();
    { const int kx = tid & 31, ny = tid >> 5;
#pragma unroll
      for (int i = ny; i < 64; i += 16) WT[(size_t)(n0 + i) * KT + k0 + kx] = f2bf(t[kx][i]); }
}
__device__ __forceinline__ void fold_unit(const P& p, unsigned char* lds, int unit) {
    float (*wf)[256] = (float (*)[256])lds;
    const int tid = tid_opaque(), li = unit >> 7, it = (unit >> 4) & 7, nt = unit & 15, i0 = it * 32, n0 = nt * 64;
    __syncthreads();
    for (int i = tid; i < 32 * 256; i += 512) wf[i >> 8][i & 255] = p.w_fnet[((size_t)li * 256 + i0 + (i >> 8)) * 256 + (i & 255)];
    __syncthreads();
    const int ii = tid >> 4, n4 = (tid & 15) * 4; const float* wo = p.w_out + ((size_t)li * 1024 + 768) * 1024 + n0 + n4;
    f32x4 s = {0.f, 0.f, 0.f, 0.f};
    for (int j = 0; j < 256; ++j) { const f32x4 w = *(const f32x4*)(wo + (size_t)j * 1024); const float a = wf[ii][j]; s[0] += a * w[0]; s[1] += a * w[1]; s[2] += a * w[2]; s[3] += a * w[3]; }
    bf16_t* o = WSP(bf16_t, WS_WOUT) + (size_t)li * DM * DM + (size_t)(n0 + n4) * DM + 768 + i0 + ii;
#pragma unroll
    for (int e = 0; e < 4; ++e) o[(size_t)e * DM] = f2bf(s[e]);
}
__device__ __forceinline__ void dftgen_elem(bf16_t* A, int L, int idx) {
    const int lp = idx / L, kk = idx % L, h = L / 2; const int k = kk <= h ? kk : kk - h;
    const int ph = (int)(((long)k * lp) % L);
    float s, c; sincospif(2.0f * (float)ph / (float)L, &s, &c);
    const float sc = rsqrtf((float)L);
    A[idx] = f2bf(kk <= h ? c * sc : -s * sc);
}
constexpr int TU_WIN = (DM / 32) * (PW / 64), TU_WOUT = (768 / 32) * (DM / 64), TU_WUP = (DM / 32) * (2 * DFF / 64), TU_WDOWN = (DFF / 32) * (DM / 64);
__device__ __forceinline__ void ffn_weight_units(const P& p, unsigned char* lds, int li, int u) {
    if (u < TU_WUP) transpose_unit(p.w_up + (size_t)li * DM * 2 * DFF, 2 * DFF, WSP(bf16_t, WS_WUP), DM, 2 * DFF / 64, u, 1, lds);
    else transpose_unit(p.w_down + (size_t)li * DFF * DM, DM, WSP(bf16_t, WS_WDOWN), DFF, DM / 64, u - TU_WUP, 0, lds);
}
__device__ __forceinline__ void ph_prologue(const P& p, unsigned char* lds) {
    const int G = gridDim.x, bid = blockIdx.x;
    if (bid == G - 1) small_tables(p);
    for (int u = bid; u < 192; u += G) adaln_unit(p, lds, u);
    for (int u = bid; u < 256; u += G) fold_unit(p, lds, u);
    constexpr int NT = 2 * TU_WIN + 2 * TU_WOUT + TU_WUP + TU_WDOWN;
    for (int u = bid; u < NT; u += G) {
        int r = u;
        if (r < 2 * TU_WIN) { const int li = r / TU_WIN; transpose_unit(p.w_in + (size_t)li * DM * PW, PW, WSP(bf16_t, WS_WIN) + (size_t)li * PW * DM, DM, PW / 64, r % TU_WIN, 0, lds); continue; } r -= 2 * TU_WIN;
        if (r < 2 * TU_WOUT) { const int li = r / TU_WOUT; transpose_unit(p.w_out + (size_t)li * DM * DM, DM, WSP(bf16_t, WS_WOUT) + (size_t)li * DM * DM, DM, DM / 64, r % TU_WOUT, 0, lds); continue; } r -= 2 * TU_WOUT;
        ffn_weight_units(p, lds, 0, r);
    }
    for (int i = bid * 512 + tid_opaque(); i < SEQ * SEQ; i += G * 512) dftgen_elem(WSP(bf16_t, WS_DFT), SEQ, i);
    for (int i = bid * 512 + tid_opaque(); i < CTX * CTX; i += G * 512) dftgen_elem(WSP(bf16_t, WS_DFTC), CTX, i);
}

__device__ __forceinline__ void ph_normmod(const float* xlat, const float* xctx, const float* w, const float* mod, bf16_t* H, int shoff, int nrows) {
    const int lane = tid_opaque() & 63, wv = tid_opaque() >> 6;
    for (int row = blockIdx.x * 8 + wv; row < nrows; row += gridDim.x * 8) {
        const float* src = row < MLAT ? xlat + (size_t)row * DM : xctx + (size_t)(row - MLAT) * DM;
        const float* mv = mod + (size_t)(row < MLAT ? (row >> 11) : 8) * 6144 + shoff;
        f32x4 v[4]; float ss = 0.f;
#pragma unroll
        for (int j = 0; j < 4; ++j) { v[j] = *(const f32x4*)(src + (lane + 64 * j) * 4); ss += v[j][0] * v[j][0] + v[j][1] * v[j][1] + v[j][2] * v[j][2] + v[j][3] * v[j][3]; }
        const float rstd = rsqrtf(wave_sum(ss) * (1.f / DM) + EPS);
#pragma unroll
        for (int j = 0; j < 4; ++j) { const int c = (lane + 64 * j) * 4;
            const f32x4 wv4 = *(const f32x4*)(w + c), sh = *(const f32x4*)(mv + c), sc = *(const f32x4*)(mv + 1024 + c);
            float o[4];
#pragma unroll
            for (int e = 0; e < 4; ++e) o[e] = (v[j][e] * rstd * wv4[e]) * (1.f + sc[e]) + sh[e];
            u32x2 pk; pk.x = pk2(o[0], o[1]); pk.y = pk2(o[2], o[3]);
            *(u32x2*)(H + (size_t)row * DM + c) = pk; }
    }
}
__device__ __forceinline__ void ph_finalnorm(float* x, const float* w, int nrows) {
    const int lane = tid_opaque() & 63, wv = tid_opaque() >> 6;
    for (int row = blockIdx.x * 8 + wv; row < nrows; row += gridDim.x * 8) {
        float* src = x + (size_t)row * DM;
        f32x4 v[4]; float ss = 0.f;
#pragma unroll
        for (int j = 0; j < 4; ++j) { v[j] = *(const f32x4*)(src + (lane + 64 * j) * 4); ss += v[j][0] * v[j][0] + v[j][1] * v[j][1] + v[j][2] * v[j][2] + v[j][3] * v[j][3]; }
        const float rstd = rsqrtf(wave_sum(ss) * (1.f / DM) + EPS);
#pragma unroll
        for (int j = 0; j < 4; ++j) { const int c = (lane + 64 * j) * 4; const f32x4 wv4 = *(const f32x4*)(w + c);
            f32x4 o; for (int e = 0; e < 4; ++e) o[e] = v[j][e] * rstd * wv4[e];
            *(f32x4*)(src + c) = o; }
    }
}

template <class Epi> __device__ __forceinline__ void ph_gemm(unsigned char* lds, const pg8::Gemm& g, const Epi& E) {
    pg8::StaticOrder S; S.init(g.M, g.N, (int)gridDim.x, (int)blockIdx.x);
    pg8::gemm_phase<Epi, pg8::StaticOrder, true, true>((LAS unsigned char*)lds, g, S, E);
}

constexpr int LS = 72;
__device__ __forceinline__ int hg_row(int b, int dir, int cs, int i) {
    int q = cs * 64 + i;
    if (q < CTX) return MLAT + b * CTX + (dir ? CTX - 1 - q : q);
    q -= CTX; return b * SEQ + (dir ? SEQ - 1 - q : q);
}
__device__ __forceinline__ f32x4 mm_tile(const bf16_t* A, const bf16_t* Bt, int tm, int tn, int lane, f32x4 acc) {
    const int r = lane & 15, q = lane >> 4;
#pragma unroll
    for (int ks = 0; ks < 2; ++ks) {
        const bf16x8 a = *(const bf16x8*)(A + (tm * 16 + r) * LS + ks * 32 + q * 8), b = *(const bf16x8*)(Bt + (tn * 16 + r) * LS + ks * 32 + q * 8);
        acc = __builtin_amdgcn_mfma_f32_16x16x32_bf16(a, b, acc, 0, 0, 0);
    }
    return acc;
}
struct HgArgs { const bf16_t* QH; const bf16_t* VH; const bf16_t* OG; const float* GF; const float* GB; bf16_t* L; float* DC; bf16_t* MIX; const float* wn; const float* lb; };
__device__ __forceinline__ void ph_hgrn_h1(unsigned char* lds, const HgArgs& A, int nunits) {
    bf16_t* K2t = (bf16_t*)lds; bf16_t* Vt = K2t + 64 * LS; float (*part)[64] = (float (*)[64])(lds + 2 * 64 * LS * 2);
    const int tid = tid_opaque(), lane = tid & 63, wid = tid >> 6, d = tid & 63, p8 = tid >> 6;
    for (int unit = blockIdx.x; unit < nunits; unit += gridDim.x) {
        const int seq = unit / NCH, cs = unit % NCH, dir = seq & 1, bh = seq >> 1, b = bh >> 2, h = bh & 3;
        const float* G = dir ? A.GB : A.GF; const float lbv = A.lb[dir * 256 + h * 64 + d];
        float g[8], c[8]; int rows[8];
#pragma unroll
        for (int e = 0; e < 8; ++e) { rows[e] = hg_row(b, dir, cs, 8 * p8 + e); g[e] = log_forget(G[(size_t)rows[e] * 256 + h * 64 + d], lbv); }
        c[0] = g[0];
#pragma unroll
        for (int e = 1; e < 8; ++e) c[e] = c[e - 1] + g[e];
        __syncthreads();
        part[p8][d] = c[7];
        __syncthreads();
        float off = 0.f, tot = 0.f;
#pragma unroll
        for (int q = 0; q < 8; ++q) { const float x = part[q][d]; tot += x; if (q < p8) off += x; }
#pragma unroll
        for (int e = 0; e < 8; ++e) { const float cc = c[e] + off; const float k = -expm1f(g[e]); K2t[d * LS + 8 * p8 + e] = f2bf(k * __expf(tot - cc)); }
#pragma unroll
        for (int e = 0; e < 8; ++e) Vt[d * LS + 8 * p8 + e] = A.VH[(size_t)rows[e] * 256 + h * 64 + d];
        if (p8 == 0) A.DC[(size_t)unit * 64 + d] = __expf(tot);
        __syncthreads();
        const int tm = wid >> 1; bf16_t* Lp = A.L + (size_t)unit * 4096;
#pragma unroll
        for (int j = 0; j < 2; ++j) { const int tn = 2 * (wid & 1) + j; f32x4 acc = {0.f, 0.f, 0.f, 0.f};
            acc = mm_tile(Vt, K2t, tm, tn, lane, acc);
#pragma unroll
            for (int r = 0; r < 4; ++r) Lp[(tm * 16 + 4 * (lane >> 4) + r) * 64 + tn * 16 + (lane & 15)] = f2bf(acc[r]); }
    }
}
__device__ __forceinline__ void ph_hgrn_scan(bf16_t* L, const float* DC) {
    for (int idx = blockIdx.x * 512 + tid_opaque(); idx < 64 * 4096; idx += gridDim.x * 512) {
        const int seq = idx >> 12, e = idx & 4095, d = e & 63;
        float S = 0.f;
        for (int cs = 0; cs < NCH; ++cs) { const size_t o = ((size_t)seq * NCH + cs) * 4096 + e; const float lv = bf2f(L[o]); L[o] = f2bf(S); S = DC[((size_t)seq * NCH + cs) * 64 + d] * S + lv; }
    }
}
__device__ __forceinline__ void ph_hgrn_h3(unsigned char* lds, const HgArgs& A, int nlat, int nunits) {
    bf16_t* Q1 = (bf16_t*)lds; bf16_t* K1 = Q1 + 64 * LS; bf16_t* Q2 = K1 + 64 * LS; bf16_t* Vt = Q2 + 64 * LS; bf16_t* St = Vt + 64 * LS; bf16_t* Sm = St + 64 * LS;
    float (*part)[64] = (float (*)[64])(lds + 6 * 64 * LS * 2); float (*Ol)[65] = (float (*)[65])(lds + 6 * 64 * LS * 2 + 8 * 64 * 4);
    const int tid = tid_opaque(), lane = tid & 63, wid = tid >> 6, d = tid & 63, p8 = tid >> 6;
    for (int unit = blockIdx.x; unit < nunits; unit += gridDim.x) {
        int b, h, J; bool ctx;
        if (unit < nlat) { ctx = false; b = unit >> 7; h = (unit >> 5) & 3; J = unit & 31; } else { const int uc = unit - nlat; ctx = true; b = uc >> 4; h = (uc >> 2) & 3; J = uc & 3; }
        for (int dir = 0; dir < 2; ++dir) {
            const int cs = ctx ? (dir ? 3 - J : J) : (dir ? 4 + 31 - J : 4 + J);
            const int seq = (b * 4 + h) * 2 + dir; const float* G = dir ? A.GB : A.GF; const float lbv = A.lb[dir * 256 + h * 64 + d];
            float g[8], c[8]; int rows[8];
#pragma unroll
            for (int e = 0; e < 8; ++e) { rows[e] = hg_row(b, dir, cs, 8 * p8 + e); g[e] = log_forget(G[(size_t)rows[e] * 256 + h * 64 + d], lbv); }
            c[0] = g[0];
#pragma unroll
            for (int e = 1; e < 8; ++e) c[e] = c[e - 1] + g[e];
            __syncthreads();
            part[p8][d] = c[7];
            __syncthreads();
            float off = 0.f, R = 0.f;
#pragma unroll
            for (int q = 0; q < 8; ++q) { const float x = part[q][d]; if (q < 4) R += x; if (q < p8) off += x; }
            const bf16_t* Sp = A.L + ((size_t)seq * NCH + cs) * 4096;
#pragma unroll
            for (int e = 0; e < 8; ++e) { const int i = 8 * p8 + e; const float cc = c[e] + off, k = -expm1f(g[e]), q = bf2f(A.QH[(size_t)rows[e] * 256 + h * 64 + d]);
                Q1[i * LS + d] = f2bf(q * __expf(cc - R)); K1[i * LS + d] = f2bf(k * __expf(R - cc)); Q2[i * LS + d] = f2bf(q * __expf(cc));
                Vt[d * LS + i] = A.VH[(size_t)rows[e] * 256 + h * 64 + d];
                St[i * LS + d] = Sp[i * 64 + d]; }
            __syncthreads();
            const int tm = wid >> 1, q4 = lane >> 4, r16 = lane & 15;
#pragma unroll
            for (int j = 0; j < 2; ++j) { const int tn = 2 * (wid & 1) + j; f32x4 acc = {0.f, 0.f, 0.f, 0.f};
                acc = mm_tile(Q1, K1, tm, tn, lane, acc);
#pragma unroll
                for (int r = 0; r < 4; ++r) { const int t = tm * 16 + 4 * q4 + r, s = tn * 16 + r16; Sm[t * LS + s] = f2bf(s <= t ? acc[r] : 0.f); } }
            __syncthreads();
#pragma unroll
            for (int j = 0; j < 2; ++j) { const int tn = 2 * (wid & 1) + j; f32x4 acc = {0.f, 0.f, 0.f, 0.f};
                acc = mm_tile(Sm, Vt, tm, tn, lane, acc);
                acc = mm_tile(Q2, St, tm, tn, lane, acc);
#pragma unroll
                for (int r = 0; r < 4; ++r) { const int t = tm * 16 + 4 * q4 + r, v = tn * 16 + r16;
                    if (dir == 0) Ol[t][v] = acc[r]; else Ol[63 - t][v] += acc[r]; } }
            __syncthreads();
        }
        {
            const int tk = tid >> 3, v0 = (tid & 7) * 8; const int row = ctx ? MLAT + b * CTX + J * 64 + tk : b * SEQ + J * 64 + tk;
            float o[8], ss = 0.f;
#pragma unroll
            for (int e = 0; e < 8; ++e) { o[e] = Ol[tk][v0 + e]; ss += o[e] * o[e]; }
            ss += __shfl_xor(ss, 1); ss += __shfl_xor(ss, 2); ss += __shfl_xor(ss, 4);
            const float rstd = rsqrtf(ss * (1.f / 64.f) + EPS);
            const u32x4 ogw = *(const u32x4*)(A.OG + (size_t)row * 256 + h * 64 + v0);
            const unsigned og[4] = {ogw.x, ogw.y, ogw.z, ogw.w};
#pragma unroll
            for (int e = 0; e < 8; ++e) { const float gt = __uint_as_float((e & 1) ? (og[e >> 1] & 0xffff0000u) : (og[e >> 1] << 16)); o[e] = o[e] * rstd * A.wn[v0 + e] * gt; }
            store8_bf16(A.MIX + (size_t)row * DM + 512 + h * 64 + v0, o);
        }
    }
}

__device__ __forceinline__ void dftprep_unit(unsigned char* lds, const bf16_t* UU, int rowbase, int L, bf16_t* Bt, int unit) {
    float (*F)[256] = (float (*)[256])lds; float (*T)[64] = (float (*)[64])(lds + 32 * 256 * 4);
    const int tid = tid_opaque(), ntile = L / 32, b = unit / ntile, k0 = (unit % ntile) * 32, hL = L / 2;
    __syncthreads();
    if (tid < 64) { float s, c; sincospif((float)tid / 32.f, &s, &c); T[0][tid] = c * 0.125f; T[1][tid] = s * 0.125f; }
    for (int i = tid; i < 32 * 256; i += 512) { const int r = i >> 8, ch = i & 255, kk = k0 + r; const int k = kk <= hL ? kk : kk - hL;
        const float a = bf2f(UU[(size_t)(rowbase + b * L + k) * 256 + ch]);
        float f;
        if (k == 0 || k == hL) f = a; else { const float bb = bf2f(UU[(size_t)(rowbase + b * L + L - k) * 256 + ch]); f = kk <= hL ? a + bb : a - bb; }
        F[r][ch] = f; }
    __syncthreads();
    const int ch = tid >> 1, half = tid & 1, g = ch >> 6, cp = ch & 63;
    float o[16];
#pragma unroll
    for (int i = 0; i < 16; ++i) o[i] = 0.f;
    for (int c = 0; c < 64; ++c) { const int ph = (c * cp) & 63; const float tc = T[0][ph], ts = T[1][ph];
#pragma unroll
        for (int i = 0; i < 16; ++i) { const int r = 16 * half + i; o[i] += F[r][g * 64 + c] * ((k0 + r) <= hL ? tc : ts); } }
    bf16_t* op = Bt + (size_t)(b * 256 + ch) * L + k0 + 16 * half;
    store8_bf16(op, o); store8_bf16(op + 8, o + 8);
}

__device__ __forceinline__ void ph_convgate(const bf16_t* U, int nrows, int seqlen, const float* conv_w, const float* conv_b, bf16_t* G, int grow0) {
    for (int idx = blockIdx.x * 512 + tid_opaque(); idx < nrows * 352; idx += gridDim.x * 512) {
        const int r = idx / 352, j0 = (idx % 352) * 8;
        const int t = r % seqlen; const bool hp = t > 0, hn = t < seqlen - 1;
        const int cg = (j0 >> 7) * 256 + (j0 & 127), cv = cg + 128;
        float og[8];
        const bf16_t* up = U + (size_t)r * 5632;
        u32x4 z; z.x = z.y = z.z = z.w = 0u;
        const u32x4 g1 = *(const u32x4*)(up + cg), v1 = *(const u32x4*)(up + cv);
        const u32x4 g0 = hp ? *(const u32x4*)(up - 5632 + cg) : z, v0 = hp ? *(const u32x4*)(up - 5632 + cv) : z;
        const u32x4 g2 = hn ? *(const u32x4*)(up + 5632 + cg) : z, v2 = hn ? *(const u32x4*)(up + 5632 + cv) : z;
        const unsigned G0[4] = {g0.x, g0.y, g0.z, g0.w}, G1[4] = {g1.x, g1.y, g1.z, g1.w}, G2[4] = {g2.x, g2.y, g2.z, g2.w};
        const unsigned V0[4] = {v0.x, v0.y, v0.z, v0.w}, V1[4] = {v1.x, v1.y, v1.z, v1.w}, V2[4] = {v2.x, v2.y, v2.z, v2.w};
#pragma unroll
        for (int e = 0; e < 8; ++e) {
            const int jg = j0 + e, jv = DFF + j0 + e;
#define UNPK(W) __uint_as_float((e & 1) ? (W[e >> 1] & 0xffff0000u) : (W[e >> 1] << 16))
            const float a = conv_w[jg] * UNPK(G0) + conv_w[2 * DFF + jg] * UNPK(G1) + conv_w[4 * DFF + jg] * UNPK(G2) + conv_b[jg];
            const float c = conv_w[jv] * UNPK(V0) + conv_w[2 * DFF + jv] * UNPK(V1) + conv_w[4 * DFF + jv] * UNPK(V2) + conv_b[jv];
#undef UNPK
            og[e] = silu_f(a) * c;
        }
        store8_bf16(G + (size_t)(grow0 + r) * DFF + j0, og);
    }
}

#define XB_TMO      128
#define XB_XCNT(j)  (256  + 64 * (j))
#define XB_XSUB(j)  (1280 + 64 * (j))
#define XB_XGEN(j)  (2304 + 64 * (j))
#define XB_TOP      3328
#define XB_TOPGEN   3392
#define XCD_BAR_WORDS 3456
#define XB_SPIN_CAP (1u << 18)

__device__ __forceinline__ unsigned xb_ld(unsigned* p)              { return __hip_atomic_load(p, __ATOMIC_RELAXED, __HIP_MEMORY_SCOPE_AGENT); }
__device__ __forceinline__ unsigned xb_add(unsigned* p, unsigned v) { return __hip_atomic_fetch_add(p, v, __ATOMIC_RELAXED, __HIP_MEMORY_SCOPE_AGENT); }
__device__ __forceinline__ unsigned xb_xcc_id() { return (unsigned)__builtin_amdgcn_s_getreg((3 << 11) | 20) & 0xFu; }
#define XB_SPIN(cond, bar) do { unsigned _sp = 0; while (cond) { __builtin_amdgcn_s_sleep(1); \
    if ((++_sp & 255u) == 0u) { if (xb_ld(&(bar)[XB_TMO])) break; if (_sp > XB_SPIN_CAP) { atomicAdd(&(bar)[XB_TMO], 1u); break; } } } } while (0)

struct XcdBarrier {
    unsigned* bar; unsigned x;
    volatile LAS unsigned* st;
};

__device__ __forceinline__ XcdBarrier xcd_barrier_post(unsigned* bar, volatile LAS unsigned* st) {
    XcdBarrier b; b.bar = bar; b.x = xb_xcc_id(); b.st = st;
    if (threadIdx.x == 0) (void)xb_add(&bar[XB_XCNT(b.x)], 1u);
    return b;
}
__device__ __forceinline__ void xcd_barrier_complete(unsigned* bar, unsigned x, unsigned& nloc, unsigned& nx) {
    const unsigned G = gridDim.x * gridDim.y * gridDim.z;
    unsigned sum, cnt, mine, sp = 0u;
    for (;;) {
        sum = 0u; cnt = 0u; mine = 0u;
#pragma unroll
        for (unsigned j = 0; j < 16; ++j) { const unsigned c = xb_ld(&bar[XB_XCNT(j)]); sum += c; cnt += (c > 0u) ? 1u : 0u; mine = (j == x) ? c : mine; }
        if (sum == G) break;
        __builtin_amdgcn_s_sleep(1);
        if ((++sp & 255u) == 0u) { if (xb_ld(&bar[XB_TMO])) break; if (sp > XB_SPIN_CAP) { atomicAdd(&bar[XB_TMO], 1u); break; } }
    }
    nloc = mine > 0u ? mine : 1u; nx = cnt > 0u ? cnt : 1u;
}

__device__ __forceinline__ void xcd_barrier(const XcdBarrier& b) {
    asm volatile("s_waitcnt vmcnt(0)" ::: "memory");
    __syncthreads();
    if (threadIdx.x == 0) {
        unsigned* bar = b.bar;
        __builtin_amdgcn_s_waitcnt(0);
        unsigned nloc = b.st[0], nx = b.st[1];
        if (nloc == 0u) { xcd_barrier_complete(bar, b.x, nloc, nx); b.st[0] = nloc; b.st[1] = nx; }
        const unsigned old = xb_add(&bar[XB_XSUB(b.x)], 1u);
        const unsigned gen = old / nloc;
        if (old + 1u == (gen + 1u) * nloc) {
            __builtin_amdgcn_fence(__ATOMIC_RELEASE, "agent");
            asm volatile("s_waitcnt vmcnt(0)" ::: "memory");
            const unsigned og = xb_add(&bar[XB_TOP], 1u);
            const unsigned tg = og / nx;
            if (og + 1u == (tg + 1u) * nx) xb_add(&bar[XB_TOPGEN], 1u);
            else XB_SPIN(xb_ld(&bar[XB_TOPGEN]) == tg, bar);
            __builtin_amdgcn_fence(__ATOMIC_ACQUIRE, "agent");
            xb_add(&bar[XB_XGEN(b.x)], 1u);
            asm volatile("s_waitcnt vmcnt(0)" ::: "memory");
        } else {
            XB_SPIN(xb_ld(&bar[XB_XGEN(b.x)]) == gen, bar);
            __builtin_amdgcn_fence(__ATOMIC_ACQUIRE, "agent");
            asm volatile("s_waitcnt vmcnt(0)" ::: "memory");
        }
    }
    __syncthreads();
}

#define REP_PRO 1
#define REP_NORM 1
#define REP_INPROJ 1
#define REP_A1 1
#define REP_H1 1
#define REP_PREP 1
#define REP_A2 1
#define REP_DFT 1
#define REP_H3 1
#define REP_UP 1
#define REP_CG 1
#define REP_SYNC 1
namespace cg = cooperative_groups;
constexpr int LDS_XB = pg8::STAGE_BYTES;
constexpr int LDS_BYTES = pg8::STAGE_BYTES + 256;
__global__ void __launch_bounds__(512, 2) mega_fwd(P p) {
    extern __shared__ __attribute__((aligned(16))) unsigned char lds[];
    cg::grid_group grid = cg::this_grid();
    float* out = p.out;
    float* MOD = WSP(float, WS_MOD); float* LAM = WSP(float, WS_LAM); float* LB = WSP(float, WS_LB); float* ROPE = WSP(float, WS_ROPE); float* STATS = WSP(float, WS_STATS);
    bf16_t* WIN = WSP(bf16_t, WS_WIN); bf16_t* WOUT = WSP(bf16_t, WS_WOUT); bf16_t* WUP = WSP(bf16_t, WS_WUP); bf16_t* WDOWN = WSP(bf16_t, WS_WDOWN);
    bf16_t* DFT = WSP(bf16_t, WS_DFT); bf16_t* DFTC = WSP(bf16_t, WS_DFTC); float* CTXX = WSP(float, WS_CTXX); bf16_t* H = WSP(bf16_t, WS_H); bf16_t* MIX = H;
    bf16_t* QA = WSP(bf16_t, WS_QA); bf16_t* KC = WSP(bf16_t, WS_KC); bf16_t* VT = WSP(bf16_t, WS_VT); bf16_t* QH = WSP(bf16_t, WS_QH); bf16_t* VH = WSP(bf16_t, WS_VH);
    bf16_t* OG = WSP(bf16_t, WS_OG); bf16_t* UU = WSP(bf16_t, WS_UU); float* GF = WSP(float, WS_GF); float* GB = WSP(float, WS_GB);
    bf16_t* LBUF = WSP(bf16_t, WS_L); float* DC = WSP(float, WS_DC); bf16_t* BT = WSP(bf16_t, WS_BT); bf16_t* BTC = WSP(bf16_t, WS_BTC);
    bf16_t* GBUF = WSP(bf16_t, WS_G); bf16_t* UCH = WSP(bf16_t, WS_UCH);
    const int G = gridDim.x, bid = blockIdx.x;
    if (tid_opaque() < 64) ((LAS unsigned*)(lds + LDS_XB))[tid_opaque()] = 0u;
    __syncthreads();
    const XcdBarrier bar = xcd_barrier_post(WSP(unsigned, WS_CTL), (volatile LAS unsigned*)(lds + LDS_XB));

    for (int rep = 0; rep < REP_PRO; ++rep) ph_prologue(p, lds);
    grid.sync();
    for (int li = 0; li < 2; ++li) {
        const bool last = li == 1; const float* mod = MOD + (size_t)li * 9 * 6144;
        const float* xl = li == 0 ? p.x : (const float*)out; const float* xc = li == 0 ? p.ctx : (const float*)CTXX;
        for (int rep = 0; rep < REP_NORM; ++rep) ph_normmod(xl, xc, p.norm1_w + li * DM, mod, H, 0, MTOT);
        if (li == 1) for (int u = bid; u < TU_WUP + TU_WDOWN; u += G) ffn_weight_units(p, lds, 1, u);
        xcd_barrier(bar);
        { pg8::Gemm g{H, WIN + (size_t)li * PW * DM, MTOT, PW, DM, 0}; EpiInProj E{QA, KC, VT, QH, VH, OG, UU, GF, GB, ROPE, LB + li * 512}; for (int rep = 0; rep < REP_INPROJ; ++rep) ph_gemm(lds, g, E); }
        xcd_barrier(bar);
        const AttnArgs AA{QA, KC, VT, STATS, MIX, LAM + li, p.subln_w + li * 128, 256, last ? 256 : 288};
        const HgArgs HA{QH, VH, OG, GF, GB, LBUF, DC, MIX, p.hgrn_norm_w + li * 64, LB + li * 512};
        for (int rep = 0; rep < REP_A1; ++rep) for (int u = bid; u < AA.nunits; u += G) attn_unit<1>(lds, AA, u);
        __syncthreads();
        for (int rep = 0; rep < REP_H1; ++rep) ph_hgrn_h1(lds, HA, 64 * NCH);
        for (int rep = 0; rep < REP_PREP; ++rep) for (int u = bid; u < NB * SEQ / 32; u += G) dftprep_unit(lds, UU, 0, SEQ, BT, u);
        if (!last) for (int u = bid; u < NB * CTX / 32; u += G) dftprep_unit(lds, UU, MLAT, CTX, BTC, u);
        xcd_barrier(bar);
        for (int rep = 0; rep < REP_A2; ++rep) for (int u = bid; u < AA.nunits; u += G) attn_unit<2>(lds, AA, u);
        ph_hgrn_scan(LBUF, DC);
        __syncthreads();
        { pg8::Gemm g{DFT, BT, SEQ, NB * 256, SEQ, 0}; EpiDft E{MIX, 0, SEQ}; for (int rep = 0; rep < REP_DFT; ++rep) ph_gemm(lds, g, E); }
        if (!last) { pg8::Gemm g{DFTC, BTC, CTX, NB * 256, CTX, 0}; EpiDft E{MIX, MLAT, CTX}; ph_gemm(lds, g, E); }
        xcd_barrier(bar);
        for (int rep = 0; rep < REP_H3; ++rep) ph_hgrn_h3(lds, HA, 1024, last ? 1024 : 1024 + 128);
        for (int rep = 0; rep < REP_SYNC; ++rep) xcd_barrier(bar);
        const int Mff = last ? MLAT : MTOT;
        { pg8::Gemm g{MIX, WOUT + (size_t)li * DM * DM, Mff, DM, DM, 0}; EpiResid E{xl, xc, out, CTXX, mod, 2048, 0}; ph_gemm(lds, g, E); }
        xcd_barrier(bar);
        ph_normmod(out, CTXX, p.norm2_w + li * DM, mod, H, 3072, Mff);
        xcd_barrier(bar);
        for (int r0 = 0; r0 < Mff; r0 += 4096) {
            const int nr = (Mff - r0) < 4096 ? (Mff - r0) : 4096;
            { pg8::Gemm g{H + (size_t)r0 * DM, WUP, nr, 2 * DFF, DM, 0}; EpiStoreBf16 E{UCH, 2 * DFF, 0}; for (int rep = 0; rep < REP_UP; ++rep) ph_gemm(lds, g, E); }
            xcd_barrier(bar);
            for (int rep = 0; rep < REP_CG; ++rep) ph_convgate(UCH, nr, r0 < MLAT ? SEQ : CTX, p.conv_w + (size_t)li * 3 * 2 * DFF, p.conv_b + (size_t)li * 2 * DFF, GBUF, r0);
            xcd_barrier(bar);
        }
        { pg8::Gemm g{GBUF, WDOWN, Mff, DM, DFF, 0}; EpiResid E{out, CTXX, out, CTXX, mod, 5120, 0}; ph_gemm(lds, g, E); }
        xcd_barrier(bar);
    }
    ph_finalnorm(out, p.final_norm_w, MLAT);
}

extern "C" void kernel_launch(void* const* d_in, const int* in_sizes, int n_in, void* d_out, int out_size, void* d_ws, size_t ws_size, hipStream_t stream) {
    static int grid = 0;
    if (grid == 0) {
        if (n_in != 20 || ws_size < WS_END || out_size != MLAT * DM) { fprintf(stderr, "kernel_launch: unexpected sizes (n_in %d, ws %zu, out %d)\n", n_in, ws_size, out_size); grid = -1; return; }
        int dev = 0, cus = 0, per_cu = 0;
        (void)hipGetDevice(&dev); (void)hipDeviceGetAttribute(&cus, hipDeviceAttributeMultiprocessorCount, dev);
        (void)hipFuncSetAttribute((const void*)mega_fwd, hipFuncAttributeMaxDynamicSharedMemorySize, LDS_BYTES);
        if (hipOccupancyMaxActiveBlocksPerMultiprocessor(&per_cu, (const void*)mega_fwd, 512, LDS_BYTES) != hipSuccess || per_cu < 1) { fprintf(stderr, "kernel_launch: occupancy query failed (%d)\n", per_cu); per_cu = 1; }
        (void)hipGetLastError();
        if (per_cu > 1) per_cu = 1;
        grid = cus * per_cu;
    }
    if (grid < 0) return;
    if (hipMemsetAsync(d_ws, 0, 64 * 1024, stream) != hipSuccess) { fprintf(stderr, "kernel_launch: hipMemsetAsync failed\n"); return; }
    P p{};
    const float** pp = (const float**)&p;
    for (int i = 0; i < 20; ++i) pp[i] = (const float*)d_in[i];
    p.out = (float*)d_out; p.ws = (unsigned char*)d_ws;
    void* args[] = {&p};
    hipError_t e = hipLaunchCooperativeKernel((const void*)mega_fwd, dim3(grid), dim3(512), args, LDS_BYTES, stream);
    if (e != hipSuccess) fprintf(stderr, "kernel_launch: cooperative launch failed: %s (grid %d)\n", hipGetErrorString(e), grid);
}
```

```cpp
#include <hip/hip_runtime.h>
#include <hip/hip_cooperative_groups.h>
#include <cstdio>
#include <cstdint>
__device__ __forceinline__ int tid_opaque() { int t = threadIdx.x; asm volatile("" : "+v"(t)); return t; }
namespace pg8 {
#define PG8_LAS __attribute__((address_space(3)))
typedef unsigned short bf16_t;
typedef short bf16x8 __attribute__((ext_vector_type(8)));
typedef float f32x4 __attribute__((ext_vector_type(4)));
typedef unsigned u32x4 __attribute__((ext_vector_type(4)));
constexpr int BM = 256, BK = 64, HALF = 128, HTB = HALF * BK * 2  , STAGE_BYTES = 8 * HTB, NXCD = 8, WGM = 8;

__host__ __device__ __forceinline__ int lds_byte(int r, int c) { const int st = (r >> 4) * 2 + (c >> 5), rr = r & 15, cc = c & 31, ob = rr * 64 + cc * 2; return st * 1024 + (ob ^ (((ob >> 9) & 1) << 5)); }
__host__ __device__ __forceinline__ void stage_rc(int b, int& R, int& C) { const int st = b / 1024, sb = b % 1024, swz = sb ^ (((sb >> 9) & 1) << 5); R = (st >> 1) * 16 + swz / 64; C = (st & 1) * 32 + (swz % 64) / 2; }
__host__ __device__ __forceinline__ int perm32(int rho) { const int n = rho >> 4, i = rho & 15; return 8 * (i >> 2) + 4 * n + (i & 3); }

struct Unit { int pm, pn; };
struct Gemm { const bf16_t* A; const bf16_t* Bt; int M, N, K, pad; };

struct StaticOrder {
    int nM, nN, nwg, G, c;
    __host__ __device__ void init(int M, int N, int G_, int c_) { nM = M / BM; nN = N / BM; nwg = nM * nN; G = G_; c = c_; }
    __host__ __device__ bool next(int i, Unit& u) const {
        const long L = (long)i * G + c; if (L >= nwg) return false;
        int wgid = (int)L; { const int q = nwg / NXCD, r = nwg % NXCD, xcd = wgid % NXCD, off = wgid / NXCD; wgid = (xcd < r ? xcd * (q + 1) : r * (q + 1) + (xcd - r) * q) + off; }
        const int nig = WGM * nN, gid = wgid / nig, fm = gid * WGM, gsz = (nM - fm) < WGM ? (nM - fm) : WGM;
        u.pm = fm + ((wgid % nig) % gsz); u.pn = (wgid % nig) / gsz; return true;
    }
    __device__ __forceinline__ long a_off(int pm, size_t tstep) const { return (long)pm * (long)tstep; }
    __device__ __forceinline__ void a_ready(const Unit&) const {}
    __device__ __forceinline__ void done(const Unit&) const {}
};

template <class Epi, class Sched, bool ALIGN_EPI = false, bool SP2 = false>
__device__ __forceinline__ void gemm_phase(PG8_LAS unsigned char* lds, const Gemm g, const Sched& S, const Epi& E) {
    const int tid = tid_opaque(), wid = __builtin_amdgcn_readfirstlane(tid >> 6), lane = tid & 63, wr = wid >> 2, wc = wid & 3, fr = lane & 15, fq = lane >> 4;
    const int K = g.K, nt = K / BK;
    unsigned voffA[2], voffB[2];
#pragma unroll
    for (int i = 0; i < 2; ++i) { int R, C; stage_rc(tid * 16 + i * 8192, R, C); const int Rb = Epi::PERM ? ((R & ~31) + perm32(R & 31)) : R;
        voffA[i] = (unsigned)(R * K + C) * 2u; voffB[i] = (unsigned)(Rb * K + C) * 2u; }
    const size_t kstep = (size_t)(BK * 2);
    const size_t hstep = (size_t)HALF * K * 2;
    const size_t tstep = 2 * hstep;
    const unsigned ldsw = (unsigned)wid * 1024u;
    const int aoff = lds_byte(wr * 64 + fr, fq * 8), boff = lds_byte(wc * 32 + fr, fq * 8);
#define PG8_SA(b, h) (((b) * 2 + (h)) * HTB)
#define PG8_SB(b, h) ((4 + (b) * 2 + (h)) * HTB)
#define PG8_STAGE(bufoff, gbase, voff) do { _Pragma("unroll") for (int _i = 0; _i < 2; ++_i) \
        __builtin_amdgcn_global_load_lds((const unsigned*)((const char*)(gbase) + (voff)[_i]), (PG8_LAS unsigned*)(lds + (bufoff) + ldsw + _i * 8192), 16, 0, 0); } while (0)
#define PG8_LDA(dst, b, h) do { _Pragma("unroll") for (int m = 0; m < 4; ++m) _Pragma("unroll") for (int k = 0; k < 2; ++k) dst[m][k] = *(const PG8_LAS bf16x8*)(lds + PG8_SA(b, h) + aoff + m * 2048 + k * 1024); } while (0)
#define PG8_LDB(dst, b, h) do { _Pragma("unroll") for (int n = 0; n < 2; ++n) _Pragma("unroll") for (int k = 0; k < 2; ++k) dst[n][k] = *(const PG8_LAS bf16x8*)(lds + PG8_SB(b, h) + boff + n * 2048 + k * 1024); } while (0)
#define PG8_MMA(ai, bj, At, Bt) do { __builtin_amdgcn_s_setprio(1); _Pragma("unroll") for (int m = 0; m < 4; ++m) _Pragma("unroll") for (int n = 0; n < 2; ++n) _Pragma("unroll") for (int k = 0; k < 2; ++k) \
        acc[ai][bj][m][n] = __builtin_amdgcn_mfma_f32_16x16x32_bf16(Bt[n][k], At[m][k], acc[ai][bj][m][n], 0, 0, 0); __builtin_amdgcn_s_setprio(0); } while (0)
#define PG8_WAIT_V(n) asm volatile("s_waitcnt vmcnt(" #n ")" ::: "memory")
#define PG8_WAIT_L(n) asm volatile("s_waitcnt lgkmcnt(" #n ")" ::: "memory")
#define PG8_BAR __builtin_amdgcn_s_barrier()
#define PG8_SCHED __builtin_amdgcn_sched_barrier(0)
    Unit cur, nxt; int ui = 0;
    if (!S.next(0, cur)) return;
    f32x4 acc[2][2][4][2];
#pragma unroll
    for (int a = 0; a < 2; ++a)
#pragma unroll
        for (int b = 0; b < 2; ++b)
#pragma unroll
            for (int m = 0; m < 4; ++m)
#pragma unroll
                for (int n = 0; n < 2; ++n) acc[a][b][m][n] = (f32x4){0.f, 0.f, 0.f, 0.f};
    bf16x8 At[4][2], B0[2][2], B1[2][2];
    const char* cA = (const char*)g.A + S.a_off(cur.pm, tstep); const char* cB = (const char*)g.Bt + (size_t)cur.pn * tstep;
    S.a_ready(cur);
    if constexpr (SP2) {
        PG8_STAGE(PG8_SB(0, 0), cB, voffB); PG8_STAGE(PG8_SB(0, 1), cB + hstep, voffB); PG8_STAGE(PG8_SA(0, 0), cA, voffA); PG8_STAGE(PG8_SA(0, 1), cA + hstep, voffA);
        if (wr == 1) PG8_BAR;
        PG8_WAIT_V(2); PG8_BAR;
        PG8_STAGE(PG8_SB(1, 0), cB + kstep, voffB); PG8_STAGE(PG8_SA(1, 0), cA + kstep, voffA); PG8_STAGE(PG8_SB(1, 1), cB + hstep + kstep, voffB);
        PG8_WAIT_V(6); PG8_BAR;
    } else {
        PG8_STAGE(PG8_SB(0, 0), cB, voffB); PG8_STAGE(PG8_SA(0, 0), cA, voffA); PG8_STAGE(PG8_SB(0, 1), cB + hstep, voffB); PG8_STAGE(PG8_SA(0, 1), cA + hstep, voffA);
        if (wr == 1) PG8_BAR;
        PG8_WAIT_V(4); PG8_BAR;
        PG8_STAGE(PG8_SB(1, 0), cB + kstep, voffB); PG8_STAGE(PG8_SA(1, 0), cA + kstep, voffA); PG8_STAGE(PG8_SB(1, 1), cB + hstep + kstep, voffB);
        PG8_WAIT_V(6); PG8_BAR;
    }
    for (;;) {
        const bool has_next = S.next(ui + 1, nxt);
        const char* nA = has_next ? (const char*)g.A + S.a_off(nxt.pm, tstep) : cA; const char* nB = has_next ? (const char*)g.Bt + (size_t)nxt.pn * tstep : cB;
        for (int t = 0; t < nt; t += 2) {
            const bool last = (t == nt - 2);
            const char* a1 = cA + (size_t)(t + 1) * kstep;
            const char* a2 = last ? nA : cA + (size_t)(t + 2) * kstep; const char* b2 = last ? nB : cB + (size_t)(t + 2) * kstep;
            const char* a3 = a2 + kstep; const char* b3 = b2 + kstep;
            if (last && has_next) S.a_ready(nxt);
            if constexpr (SP2) {
            PG8_LDB(B0, 0, 0); PG8_LDB(B1, 0, 1); PG8_SCHED; PG8_LDA(At, 0, 0); PG8_STAGE(PG8_SA(1, 1), a1 + hstep, voffA);
            PG8_WAIT_V(8); PG8_WAIT_L(0); PG8_BAR; PG8_MMA(0, 0, At, B0); PG8_MMA(0, 1, At, B1); PG8_BAR; PG8_SCHED;
            PG8_LDA(At, 0, 1); PG8_STAGE(PG8_SB(0, 0), b2, voffB); PG8_STAGE(PG8_SB(0, 1), b2 + hstep, voffB); PG8_STAGE(PG8_SA(0, 0), a2, voffA);
            PG8_WAIT_V(8); PG8_WAIT_L(0); PG8_BAR; PG8_MMA(1, 0, At, B0); PG8_MMA(1, 1, At, B1); PG8_BAR; PG8_SCHED;
            PG8_LDB(B0, 1, 0); PG8_LDB(B1, 1, 1); PG8_SCHED; PG8_LDA(At, 1, 0); PG8_STAGE(PG8_SA(0, 1), a2 + hstep, voffA);
            PG8_WAIT_V(8); PG8_WAIT_L(0); PG8_BAR; PG8_MMA(0, 0, At, B0); PG8_MMA(0, 1, At, B1); PG8_BAR; PG8_SCHED;
            PG8_LDA(At, 1, 1); PG8_STAGE(PG8_SB(1, 0), b3, voffB); PG8_STAGE(PG8_SB(1, 1), b3 + hstep, voffB); PG8_STAGE(PG8_SA(1, 0), a3, voffA);
            PG8_WAIT_V(8); PG8_WAIT_L(0); PG8_BAR; PG8_MMA(1, 0, At, B0); PG8_MMA(1, 1, At, B1); PG8_BAR; PG8_SCHED;
            } else {
            PG8_LDB(B0, 0, 0); PG8_SCHED; PG8_LDA(At, 0, 0); PG8_STAGE(PG8_SA(1, 1), a1 + hstep, voffA);
            PG8_WAIT_L(8); PG8_BAR; PG8_WAIT_L(0); PG8_MMA(0, 0, At, B0); PG8_BAR; PG8_SCHED;
            PG8_LDB(B1, 0, 1); PG8_STAGE(PG8_SB(0, 0), b2, voffB);
            PG8_BAR; PG8_WAIT_L(0); PG8_MMA(0, 1, At, B1); PG8_BAR;
            PG8_LDA(At, 0, 1); PG8_STAGE(PG8_SA(0, 0), a2, voffA);
            PG8_BAR; PG8_WAIT_L(0); PG8_MMA(1, 0, At, B0); PG8_BAR; PG8_SCHED;
            PG8_STAGE(PG8_SB(0, 1), b2 + hstep, voffB);
            PG8_WAIT_V(6); PG8_BAR; PG8_MMA(1, 1, At, B1); PG8_BAR;
            PG8_LDB(B0, 1, 0); PG8_SCHED; PG8_LDA(At, 1, 0); PG8_STAGE(PG8_SA(0, 1), a2 + hstep, voffA);
            PG8_WAIT_L(8); PG8_BAR; PG8_WAIT_L(0); PG8_MMA(0, 0, At, B0); PG8_BAR; PG8_SCHED;
            PG8_LDB(B1, 1, 1); PG8_STAGE(PG8_SB(1, 0), b3, voffB);
            PG8_BAR; PG8_WAIT_L(0); PG8_MMA(0, 1, At, B1); PG8_BAR;
            PG8_LDA(At, 1, 1); PG8_STAGE(PG8_SA(1, 0), a3, voffA);
            PG8_BAR; PG8_WAIT_L(0); PG8_MMA(1, 0, At, B0); PG8_BAR; PG8_SCHED;
            PG8_STAGE(PG8_SB(1, 1), b3 + hstep, voffB);
            PG8_WAIT_V(6); PG8_BAR; PG8_MMA(1, 1, At, B1); PG8_BAR;
            }
        }
        if constexpr (ALIGN_EPI) { if (wr == 0) PG8_BAR; }
        if constexpr (!Epi::AFTER_DRAIN) { E(acc, cur, wr, wc, fr, fq); S.done(cur); }
        if (!has_next) break;
#pragma unroll
        for (int a = 0; a < 2; ++a)
#pragma unroll
            for (int b = 0; b < 2; ++b)
#pragma unroll
                for (int m = 0; m < 4; ++m)
#pragma unroll
                    for (int n = 0; n < 2; ++n) acc[a][b][m][n] = (f32x4){0.f, 0.f, 0.f, 0.f};
        cur = nxt; cA = nA; cB = nB; ++ui;
        if constexpr (ALIGN_EPI) { if (wr == 1) PG8_BAR; }
    }
    PG8_WAIT_V(0);
    if constexpr (!ALIGN_EPI) { if (wr == 0) PG8_BAR; }
    PG8_BAR;
    if constexpr (Epi::AFTER_DRAIN) { E.fused(acc, cur, wr, wc, fr, fq, lds, wid, lane); S.done(cur); }
#undef PG8_SA
#undef PG8_SB
#undef PG8_STAGE
#undef PG8_LDA
#undef PG8_LDB
#undef PG8_MMA
#undef PG8_WAIT_V
#undef PG8_WAIT_L
#undef PG8_BAR
#undef PG8_SCHED
}
}

using pg8::bf16_t; using pg8::bf16x8; using pg8::f32x4;
typedef float f32x16 __attribute__((ext_vector_type(16)));
typedef short s16x4 __attribute__((ext_vector_type(4)));
typedef unsigned u32x4 __attribute__((ext_vector_type(4)));
typedef unsigned u32x2 __attribute__((ext_vector_type(2)));
#define LAS __attribute__((address_space(3)))

constexpr int DM = 1024, NB = 8, SEQ = 2048, CTX = 256, MLAT = NB * SEQ, MCTX = NB * CTX, MTOT = MLAT + MCTX;
constexpr int PW = 3072, DFF = 2816, KEYS = SEQ + CTX, NCH = 36  ;
constexpr float EPS = 1e-6f;
constexpr float QSCALE = 0.125f * 1.4426950408889634f;

constexpr size_t MiB = 1u << 20;
constexpr size_t WS_CTL = 0;
constexpr size_t WS_MOD = 64 * 1024;
constexpr size_t WS_LAM = 512 * 1024;
constexpr size_t WS_LB = WS_LAM + 256;
constexpr size_t WS_ROPE = WS_LB + 4096;
constexpr size_t WS_STATS = 1 * MiB;
constexpr size_t WS_WIN = 4 * MiB;
constexpr size_t WS_WOUT = 16 * MiB;
constexpr size_t WS_WUP = 21 * MiB;
constexpr size_t WS_WDOWN = 32 * MiB;
constexpr size_t WS_DFT = 38 * MiB;
constexpr size_t WS_DFTC = 46 * MiB;
constexpr size_t WS_CTXX = 47 * MiB;
constexpr size_t WS_H = 55 * MiB;
constexpr size_t WS_QA = 91 * MiB;
constexpr size_t WS_KC = 109 * MiB;
constexpr size_t WS_VT = 127 * MiB;
constexpr size_t WS_QH = 145 * MiB;
constexpr size_t WS_VH = 154 * MiB;
constexpr size_t WS_OG = 163 * MiB;
constexpr size_t WS_UU = 172 * MiB;
constexpr size_t WS_GF = 181 * MiB;
constexpr size_t WS_GB = 199 * MiB;
constexpr size_t WS_L = 217 * MiB;
constexpr size_t WS_DC = 235 * MiB;
constexpr size_t WS_BT = 236 * MiB;
constexpr size_t WS_BTC = 244 * MiB;
constexpr size_t WS_FOLD = 245 * MiB;
constexpr size_t WS_G = 91 * MiB;
constexpr size_t WS_UCH = 190 * MiB;
constexpr size_t WS_END = 248 * MiB;

__device__ __forceinline__ bf16_t f2bf(float f) { unsigned u = __float_as_uint(f); return (bf16_t)((u + 0x7fffu + ((u >> 16) & 1u)) >> 16); }
__device__ __forceinline__ float bf2f(bf16_t h) { return __uint_as_float(((unsigned)h) << 16); }
__device__ __forceinline__ unsigned pk2(float lo, float hi) { return (unsigned)f2bf(lo) | ((unsigned)f2bf(hi) << 16); }
__device__ __forceinline__ float silu_f(float v) { return v / (1.f + __expf(-v)); }
__device__ __forceinline__ float wave_sum(float v) {
#pragma unroll
    for (int o = 1; o < 64; o <<= 1) v += __shfl_xor(v, o);
    return v;
}

template <class F> __device__ __forceinline__ void epi_for_each(const f32x4 (&acc)[2][2][4][2], const pg8::Unit& u, int wr, int wc, int fr, int fq, F f) {
#pragma unroll
    for (int ai = 0; ai < 2; ++ai)
#pragma unroll
        for (int m = 0; m < 4; ++m) { const int row = u.pm * 256 + ai * 128 + wr * 64 + m * 16 + fr;
#pragma unroll
            for (int bj = 0; bj < 2; ++bj) { const int col = u.pn * 256 + bj * 128 + wc * 32 + fq * 8;
                float v[8];
#pragma unroll
                for (int e = 0; e < 4; ++e) { v[e] = acc[ai][bj][m][0][e]; v[4 + e] = acc[ai][bj][m][1][e]; }
                f(row, col, v); } }
}
__device__ __forceinline__ void store8_bf16(bf16_t* p, const float* v) { u32x4 w; w.x = pk2(v[0], v[1]); w.y = pk2(v[2], v[3]); w.z = pk2(v[4], v[5]); w.w = pk2(v[6], v[7]); *(u32x4*)p = w; }

struct EpiStoreBf16 {
    static constexpr bool PERM = true, AFTER_DRAIN = false;
    bf16_t* O; int ldc, pad;
    __device__ __forceinline__ void operator()(const f32x4 (&acc)[2][2][4][2], const pg8::Unit& u, int wr, int wc, int fr, int fq) const {
        epi_for_each(acc, u, wr, wc, fr, fq, [&](int row, int col, float* v) __attribute__((always_inline)) { store8_bf16(O + (size_t)row * ldc + col, v); });
    }
};
struct EpiDft {
    static constexpr bool PERM = true, AFTER_DRAIN = false;
    bf16_t* MIX; int rowbase, L;
    __device__ __forceinline__ void operator()(const f32x4 (&acc)[2][2][4][2], const pg8::Unit& u, int wr, int wc, int fr, int fq) const {
        epi_for_each(acc, u, wr, wc, fr, fq, [&](int row, int col, float* v) __attribute__((always_inline)) { const int b = col >> 8, ch = col & 255; store8_bf16(MIX + (size_t)(rowbase + b * L + row) * DM + 768 + ch, v); });
    }
};
struct EpiResid {
    static constexpr bool PERM = true, AFTER_DRAIN = false;
    const float* xin_lat; const float* xin_ctx; float* xout_lat; float* xout_ctx; const float* mod; int goff, pad;
    __device__ __forceinline__ void operator()(const f32x4 (&acc)[2][2][4][2], const pg8::Unit& u, int wr, int wc, int fr, int fq) const {
        const bool ctx = u.pm >= 64; const float* gv = mod + (size_t)(ctx ? 8 : (u.pm >> 3)) * 6144 + goff;
        const float* xi = ctx ? xin_ctx - (size_t)MLAT * DM : xin_lat; float* xo = ctx ? xout_ctx - (size_t)MLAT * DM : xout_lat;
        epi_for_each(acc, u, wr, wc, fr, fq, [&](int row, int col, float* v) __attribute__((always_inline)) {
            const size_t off = (size_t)row * DM + col; const f32x4 g0 = *(const f32x4*)(gv + col), g1 = *(const f32x4*)(gv + col + 4);
            const f32x4 x0 = *(const f32x4*)(xi + off), x1 = *(const f32x4*)(xi + off + 4); f32x4 o0, o1;
            for (int e = 0; e < 4; ++e) { o0[e] = x0[e] + g0[e] * v[e]; o1[e] = x1[e] + g1[e] * v[4 + e]; }
            *(f32x4*)(xo + off) = o0; *(f32x4*)(xo + off + 4) = o1; });
    }
};
__device__ __forceinline__ float log_forget(float z, float lb) {
    const float e = __expf(-fabsf(z)), r = __builtin_amdgcn_rcpf(1.f + e);
    if (lb <= 0.f) { const float l1p = e < 0.01f ? e * (1.f - e * (0.5f - e * 0.33333333f)) : __logf(1.f + e); return fminf(z, 0.f) - l1p; }
    const float k = (1.f - lb) * (z >= 0.f ? e * r : r);
    return k < 0.01f ? -k * (1.f + k * (0.5f + k * 0.33333333f)) : __logf(1.f - k);
}
struct EpiInProj {
    static constexpr bool PERM = true, AFTER_DRAIN = false;
    bf16_t *QA, *KC, *VT, *QH, *VH, *OG, *UU; float *GF, *GB; const float* rope; const float* lb;
    __device__ __forceinline__ void operator()(const f32x4 (&acc)[2][2][4][2], const pg8::Unit& u, int wr, int wc, int fr, int fq) const {
        const int pn = u.pn; const bool ctx = u.pm >= 64;
        if (pn < 4) {
            epi_for_each(acc, u, wr, wc, fr, fq, [&](int row, int col, float* v) __attribute__((always_inline)) {
                int b, t; if (ctx) { const int rc = row - MLAT; b = rc >> 8; t = rc & 255; } else { b = row >> 11; t = row & 2047; }
                if (!ctx) {
                    const int cl = col & 63, gi = cl >> 5, i0 = cl & 31, j0 = i0 & 15; const bool second = i0 >= 16;
                    const int pos = gi ? (t & 63) : (t >> 6);
                    const float* ct = rope + pos * 16 + j0; const f32x4 c0 = *(const f32x4*)ct, c1 = *(const f32x4*)(ct + 4), s0 = *(const f32x4*)(ct + 1024), s1 = *(const f32x4*)(ct + 1028);
#pragma unroll
                    for (int e = 0; e < 8; ++e) { const float pr = __shfl_xor(v[e], 32); const float cs = e < 4 ? c0[e & 3] : c1[e & 3], sn = e < 4 ? s0[e & 3] : s1[e & 3]; v[e] = second ? v[e] * cs + pr * sn : v[e] * cs - pr * sn; }
                }
                if (pn < 2) {
#pragma unroll
                    for (int e = 0; e < 8; ++e) v[e] *= QSCALE;
                    store8_bf16(QA + (size_t)row * 512 + col, v);
                } else store8_bf16(KC + (size_t)(b * KEYS + (ctx ? t : CTX + t)) * 512 + (col - 512), v);
                asm volatile("" ::: "memory"); });
        } else if (pn < 6) {
            epi_for_each(acc, u, wr, wc, fr, fq, [&](int row, int col, float* v) __attribute__((always_inline)) {
                int b, t; if (ctx) { const int rc = row - MLAT; b = rc >> 8; t = rc & 255; } else { b = row >> 11; t = row & 2047; }
                const int cc = col - 1024, hh = cc >> 7, dv = cc & 127, key = ctx ? t : CTX + t;
                bf16_t* p = VT + ((size_t)((b * 4 + hh) * 128 + dv)) * KEYS + key;
#pragma unroll
                for (int e = 0; e < 8; ++e) p[(size_t)e * KEYS] = f2bf(v[e]);
                asm volatile("" ::: "memory"); });
        } else if (pn == 7 || pn == 8) {
            const float* lbp0 = lb + (pn == 7 ? 0 : 256) - (pn == 7 ? 1792 : 2048); float* G0 = (pn == 7 ? GF : GB) - (pn == 7 ? 1792 : 2048);
            epi_for_each(acc, u, wr, wc, fr, fq, [&](int row, int col, float* v) __attribute__((always_inline)) {
                const float* lbp = lbp0 + col; float* G = G0 + (size_t)row * 256 + col;
                (void)lbp; f32x4 o0, o1;
#pragma unroll
                for (int e = 0; e < 4; ++e) { o0[e] = v[e]; o1[e] = v[4 + e]; }
                *(f32x4*)G = o0; *(f32x4*)(G + 4) = o1;
                asm volatile("" ::: "memory"); });
        } else {
            bf16_t* dst = pn == 6 ? QH : pn == 9 ? VH : pn == 10 ? OG : UU; const int c0 = pn * 256; const bool act = pn == 10;
            epi_for_each(acc, u, wr, wc, fr, fq, [&](int row, int col, float* v) __attribute__((always_inline)) {
                if (act) {
#pragma unroll
                    for (int e = 0; e < 8; ++e) v[e] = silu_f(v[e]);
                }
                store8_bf16(dst + (size_t)row * 256 + (col - c0), v);
                asm volatile("" ::: "memory"); });
        }
    }
};

constexpr int KS_STRIDE = 272, VS_STRIDE = 136;
struct AttnArgs { const bf16_t* QA; const bf16_t* KC; const bf16_t* VT; float* STATS; bf16_t* MIX; const float* lamp; const float* subw; int nlat, nunits; };
template <int PASS> __device__ __forceinline__ void attn_unit(unsigned char* lds, const AttnArgs& A, int unit) {
    const int tid = tid_opaque(), lane = tid & 63, wid = tid >> 6, r32 = lane & 31, hi = lane >> 5;
    int b, h, qrow0, nkeys;
    if (unit < A.nlat) { b = unit >> 5; h = (unit >> 3) & 3; qrow0 = b * SEQ + (unit & 7) * 256; nkeys = KEYS; }
    else { const int uc = unit - A.nlat; b = uc >> 2; h = uc & 3; qrow0 = MLAT + b * CTX; nkeys = CTX; }
    unsigned char* Ks = lds; unsigned char* Vs = lds + 64 * KS_STRIDE;
    const int qrow = qrow0 + wid * 32 + r32;
    bf16x8 qf[2][4];
    { const bf16_t* qp = A.QA + (size_t)qrow * 512 + h * 128 + hi * 8;
#pragma unroll
      for (int c = 0; c < 2; ++c)
#pragma unroll
          for (int s = 0; s < 4; ++s) qf[c][s] = *(const bf16x8*)(qp + c * 64 + s * 16); }
    const float lam = A.lamp[0];
    float m0 = -1e30f, m1 = -1e30f, l0 = 0.f, l1 = 0.f, nM0 = 0.f, nM1 = 0.f;
    f32x16 O[4];
    if (PASS == 2) { nM0 = -A.STATS[(size_t)qrow * 8 + h * 2]; nM1 = -A.STATS[(size_t)qrow * 8 + h * 2 + 1];
#pragma unroll
        for (int d = 0; d < 4; ++d)
#pragma unroll
            for (int r = 0; r < 16; ++r) O[d][r] = 0.f; }
    const bf16_t* kbase = A.KC + (size_t)b * KEYS * 512 + h * 128;
    const bf16_t* vbase = A.VT + (size_t)((b * 4 + h) * 128) * KEYS;
    for (int t0 = 0; t0 < nkeys; t0 += 64) {
        __syncthreads();
#pragma unroll
        for (int i = 0; i < 2; ++i) { const int idx = tid + 512 * i, row = idx >> 4, ch = idx & 15;
            *(u32x4*)(Ks + row * KS_STRIDE + ch * 16) = *(const u32x4*)(kbase + (size_t)(t0 + row) * 512 + ch * 8); }
        if (PASS == 2) {
#pragma unroll
            for (int i = 0; i < 2; ++i) { const int idx = tid + 512 * i, row = idx >> 3, ch = idx & 7;
                const u32x4 w = *(const u32x4*)(vbase + (size_t)row * KEYS + t0 + ch * 8);
                u32x2 a, c2; a.x = w.x; a.y = w.y; c2.x = w.z; c2.y = w.w;
                *(u32x2*)(Vs + row * VS_STRIDE + ch * 16) = a; *(u32x2*)(Vs + row * VS_STRIDE + ch * 16 + 8) = c2; }
        }
        __syncthreads();
#pragma unroll
        for (int kb = 0; kb < 2; ++kb) {
            f32x16 S0, S1;
#pragma unroll
            for (int r = 0; r < 16; ++r) { S0[r] = nM0; S1[r] = nM1; }
            const unsigned char* kp = Ks + (kb * 32 + r32) * KS_STRIDE + hi * 16;
#pragma unroll
            for (int s = 0; s < 4; ++s) {
                const bf16x8 k0 = *(const bf16x8*)(kp + s * 32), k1 = *(const bf16x8*)(kp + 128 + s * 32);
                S0 = __builtin_amdgcn_mfma_f32_32x32x16_bf16(k0, qf[0][s], S0, 0, 0, 0);
                S1 = __builtin_amdgcn_mfma_f32_32x32x16_bf16(k1, qf[1][s], S1, 0, 0, 0);
            }
            if (PASS == 1) {
                float x0 = S0[0], x1 = S1[0];
#pragma unroll
                for (int r = 1; r < 16; ++r) { x0 = fmaxf(x0, S0[r]); x1 = fmaxf(x1, S1[r]); }
                x0 = fmaxf(x0, __shfl_xor(x0, 32)); x1 = fmaxf(x1, __shfl_xor(x1, 32));
                const float n0 = fmaxf(m0, x0), n1 = fmaxf(m1, x1);
                float a0 = 0.f, a1 = 0.f;
#pragma unroll
                for (int r = 0; r < 16; ++r) { a0 += __builtin_amdgcn_exp2f(S0[r] - n0); a1 += __builtin_amdgcn_exp2f(S1[r] - n1); }
                l0 = l0 * __builtin_amdgcn_exp2f(m0 - n0) + a0; l1 = l1 * __builtin_amdgcn_exp2f(m1 - n1) + a1; m0 = n0; m1 = n1;
            } else {
                bf16x8 pa[2];
#pragma unroll
                for (int sp = 0; sp < 2; ++sp) { float a[8];
#pragma unroll
                    for (int j = 0; j < 8; ++j) a[j] = __builtin_amdgcn_exp2f(S0[8 * sp + j]) - lam * __builtin_amdgcn_exp2f(S1[8 * sp + j]);
                    u32x4 w; w.x = pk2(a[0], a[1]); w.y = pk2(a[2], a[3]); w.z = pk2(a[4], a[5]); w.w = pk2(a[6], a[7]);
                    pa[sp] = __builtin_bit_cast(bf16x8, w); }
#pragma unroll
                for (int d = 0; d < 4; ++d)
#pragma unroll
                    for (int sp = 0; sp < 2; ++sp) {
                        const unsigned char* vp = Vs + (d * 32 + r32) * VS_STRIDE + (kb * 32 + 16 * sp + 4 * hi) * 2;
                        const s16x4 lo = *(const s16x4*)vp, hh = *(const s16x4*)(vp + 16);
                        const bf16x8 vf = (bf16x8){lo[0], lo[1], lo[2], lo[3], hh[0], hh[1], hh[2], hh[3]};
                        O[d] = __builtin_amdgcn_mfma_f32_32x32x16_bf16(vf, pa[sp], O[d], 0, 0, 0);
                    }
            }
        }
    }
    if (PASS == 1) {
        l0 += __shfl_xor(l0, 32); l1 += __shfl_xor(l1, 32);
        if (hi == 0) { A.STATS[(size_t)qrow * 8 + h * 2] = m0 + __log2f(l0); A.STATS[(size_t)qrow * 8 + h * 2 + 1] = m1 + __log2f(l1); }
    } else {
        float ss = 0.f;
#pragma unroll
        for (int d = 0; d < 4; ++d)
#pragma unroll
            for (int r = 0; r < 16; ++r) ss += O[d][r] * O[d][r];
        ss += __shfl_xor(ss, 32);
        const float sc = rsqrtf(ss * (1.f / 128.f) + EPS) * A.lamp[2];
        bf16_t* op = A.MIX + (size_t)qrow * DM + h * 128;
#pragma unroll
        for (int d = 0; d < 4; ++d)
#pragma unroll
            for (int g = 0; g < 4; ++g) { const int dv = d * 32 + 8 * g + 4 * hi; const f32x4 w = *(const f32x4*)(A.subw + dv);
                u32x2 pk; pk.x = pk2(O[d][4 * g] * sc * w[0], O[d][4 * g + 1] * sc * w[1]); pk.y = pk2(O[d][4 * g + 2] * sc * w[2], O[d][4 * g + 3] * sc * w[3]);
                *(u32x2*)(op + dv) = pk; }
    }
}

struct P {
    const float *x, *c, *ctx, *c_ctx, *w_ada, *b_ada, *norm1_w, *norm2_w, *w_in, *lam_qk, *subln_w, *lb_param, *hgrn_norm_w, *w_fnet, *w_out, *w_up, *conv_w, *conv_b, *w_down, *final_norm_w;
    float* out; unsigned char* ws;
};
#define WSP(T, off) ((T*)(p.ws + (off)))

__device__ __forceinline__ void small_tables(const P& p) {
    const int tid = tid_opaque(); float* lam_out = WSP(float, WS_LAM); float* lb_out = WSP(float, WS_LB); float* rope = WSP(float, WS_ROPE);
    if (tid < 2) {
        const float* q = p.lam_qk + tid * 256; float s1 = 0.f, s2 = 0.f;
        for (int i = 0; i < 64; ++i) { s1 += q[i] * q[64 + i]; s2 += q[128 + i] * q[192 + i]; }
        const float lam_init = 0.8f - 0.6f * expf(-0.3f * (float)tid);
        lam_out[tid] = expf(s1) - expf(s2) + lam_init; lam_out[2 + tid] = 1.f - lam_init;
    }
    for (int i = tid; i < 512; i += 512) { const float p0 = p.lb_param[i], p1 = p.lb_param[512 + i]; lb_out[i] = 0.f; lb_out[512 + i] = 1.f / (1.f + expf(p0 - p1)); }
    for (int i = tid; i < 1024; i += 512) { const int pos = i >> 4, j = i & 15; const double f = pow(10000.0, -(double)j / 16.0), a = (double)pos * f; rope[i] = (float)cos(a); rope[1024 + i] = (float)sin(a); }
}
__device__ __forceinline__ void adaln_unit(const P& p, unsigned char* lds, int unit) {
    float (*cs)[1024] = (float (*)[1024])lds; float (*red)[9][64] = (float (*)[9][64])(lds + 9 * 1024 * 4);
    const int tid = tid_opaque(), li = unit / 96, nb = unit % 96, n = nb * 64 + (tid & 63), ks = tid >> 6; float* mod = WSP(float, WS_MOD);
    __syncthreads();
    for (int i = tid; i < 9 * 1024; i += 512) { const int r = i >> 10, k = i & 1023; const float v = r < 8 ? p.c[r * 1024 + k] : p.c_ctx[k]; cs[r][k] = silu_f(v); }
    __syncthreads();
    float acc[9];
#pragma unroll
    for (int r = 0; r < 9; ++r) acc[r] = 0.f;
    const float* W = p.w_ada + (size_t)li * 1024 * 6144 + n;
#pragma unroll 4
    for (int k = ks * 128; k < ks * 128 + 128; ++k) { const float w = W[(size_t)k * 6144];
#pragma unroll
        for (int r = 0; r < 9; ++r) acc[r] += cs[r][k] * w; }
#pragma unroll
    for (int r = 0; r < 9; ++r) red[ks][r][tid & 63] = acc[r];
    __syncthreads();
    for (int i = tid; i < 9 * 64; i += 512) { const int r = i >> 6, nn = i & 63; float s = p.b_ada[li * 6144 + nb * 64 + nn];
        for (int q = 0; q < 8; ++q) s += red[q][r][nn];
        mod[((size_t)li * 9 + r) * 6144 + nb * 64 + nn] = s; }
}
__device__ __forceinline__ void transpose_unit(const float* W, int N, bf16_t* WT, int KT, int nt64, int unit, int upperm, unsigned char* lds) {
    float (*t)[65] = (float (*)[65])lds;
    const int tid = tid_opaque(), k0 = (unit / nt64) * 32, n0 = (unit % nt64) * 64;
    __syncthreads();
    { const int tx = tid & 63, ty = tid >> 6; const int np = n0 + tx; int col = np;
      if (upperm) { const int tile = np >> 8, w = np & 255; col = w < 128 ? tile * 128 + w : DFF + tile * 128 + (w - 128); }
#pragma unroll
      for (int i = ty; i < 32; i += 8) t[i][tx] = W[(size_t)(k0 + i) * N + col]; }
    __syncthreads();
    { const int kx = tid & 31, ny = tid >> 5;
#pragma unroll
      for (int i = ny; i < 64; i += 16) WT[(size_t)(n0 + i) * KT + k0 + kx] = f2bf(t[kx][i]); }
}
__device__ __forceinline__ void fold_unit(const P& p, unsigned char* lds, int unit) {
    float (*wf)[256] = (float (*)[256])lds;
    const int tid = tid_opaque(), li = unit >> 7, it = (unit >> 4) & 7, nt = unit & 15, i0 = it * 32, n0 = nt * 64;
    __syncthreads();
    for (int i = tid; i < 32 * 256; i += 512) wf[i >> 8][i & 255] = p.w_fnet[((size_t)li * 256 + i0 + (i >> 8)) * 256 + (i & 255)];
    __syncthreads();
    const int ii = tid >> 4, n4 = (tid & 15) * 4; const float* wo = p.w_out + ((size_t)li * 1024 + 768) * 1024 + n0 + n4;
    f32x4 s = {0.f, 0.f, 0.f, 0.f};
    for (int j = 0; j < 256; ++j) { const f32x4 w = *(const f32x4*)(wo + (size_t)j * 1024); const float a = wf[ii][j]; s[0] += a * w[0]; s[1] += a * w[1]; s[2] += a * w[2]; s[3] += a * w[3]; }
    bf16_t* o = WSP(bf16_t, WS_WOUT) + (size_t)li * DM * DM + (size_t)(n0 + n4) * DM + 768 + i0 + ii;
#pragma unroll
    for (int e = 0; e < 4; ++e) o[(size_t)e * DM] = f2bf(s[e]);
}
__device__ __forceinline__ void dftgen_elem(bf16_t* A, int L, int idx) {
    const int lp = idx / L, kk = idx % L, h = L / 2; const int k = kk <= h ? kk : kk - h;
    const int ph = (int)(((long)k * lp) % L);
    float s, c; sincospif(2.0f * (float)ph / (float)L, &s, &c);
    const float sc = rsqrtf((float)L);
    A[idx] = f2bf(kk <= h ? c * sc : -s * sc);
}
constexpr int TU_WIN = (DM / 32) * (PW / 64), TU_WOUT = (768 / 32) * (DM / 64), TU_WUP = (DM / 32) * (2 * DFF / 64), TU_WDOWN = (DFF / 32) * (DM / 64);
__device__ __forceinline__ void ffn_weight_units(const P& p, unsigned char* lds, int li, int u) {
    if (u < TU_WUP) transpose_unit(p.w_up + (size_t)li * DM * 2 * DFF, 2 * DFF, WSP(bf16_t, WS_WUP), DM, 2 * DFF / 64, u, 1, lds);
    else transpose_unit(p.w_down + (size_t)li * DFF * DM, DM, WSP(bf16_t, WS_WDOWN), DFF, DM / 64, u - TU_WUP, 0, lds);
}
__device__ __forceinline__ void ph_prologue(const P& p, unsigned char* lds) {
    const int G = gridDim.x, bid = blockIdx.x;
    if (bid == G - 1) small_tables(p);
    for (int u = bid; u < 192; u += G) adaln_unit(p, lds, u);
    for (int u = bid; u < 256; u += G) fold_unit(p, lds, u);
    constexpr int NT = 2 * TU_WIN + 2 * TU_WOUT + TU_WUP + TU_WDOWN;
    for (int u = bid; u < NT; u += G) {
        int r = u;
        if (r < 2 * TU_WIN) { const int li = r / TU_WIN; transpose_unit(p.w_in + (size_t)li * DM * PW, PW, WSP(bf16_t, WS_WIN) + (size_t)li * PW * DM, DM, PW / 64, r % TU_WIN, 0, lds); continue; } r -= 2 * TU_WIN;
        if (r < 2 * TU_WOUT) { const int li = r / TU_WOUT; transpose_unit(p.w_out + (size_t)li * DM * DM, DM, WSP(bf16_t, WS_WOUT) + (size_t)li * DM * DM, DM, DM / 64, r % TU_WOUT, 0, lds); continue; } r -= 2 * TU_WOUT;
        ffn_weight_units(p, lds, 0, r);
    }
    for (int i = bid * 512 + tid_opaque(); i < SEQ * SEQ; i += G * 512) dftgen_elem(WSP(bf16_t, WS_DFT), SEQ, i);
    for (int i = bid * 512 + tid_opaque(); i < CTX * CTX; i += G * 512) dftgen_elem(WSP(bf16_t, WS_DFTC), CTX, i);
}

__device__ __forceinline__ void ph_normmod(const float* xlat, const float* xctx, const float* w, const float* mod, bf16_t* H, int shoff, int nrows) {
    const int lane = tid_opaque() & 63, wv = tid_opaque() >> 6;
    for (int row = blockIdx.x * 8 + wv; row < nrows; row += gridDim.x * 8) {
        const float* src = row < MLAT ? xlat + (size_t)row * DM : xctx + (size_t)(row - MLAT) * DM;
        const float* mv = mod + (size_t)(row < MLAT ? (row >> 11) : 8) * 6144 + shoff;
        f32x4 v[4]; float ss = 0.f;
#pragma unroll
        for (int j = 0; j < 4; ++j) { v[j] = *(const f32x4*)(src + (lane + 64 * j) * 4); ss += v[j][0] * v[j][0] + v[j][1] * v[j][1] + v[j][2] * v[j][2] + v[j][3] * v[j][3]; }
        const float rstd = rsqrtf(wave_sum(ss) * (1.f / DM) + EPS);
#pragma unroll
        for (int j = 0; j < 4; ++j) { const int c = (lane + 64 * j) * 4;
            const f32x4 wv4 = *(const f32x4*)(w + c), sh = *(const f32x4*)(mv + c), sc = *(const f32x4*)(mv + 1024 + c);
            float o[4];
#pragma unroll
            for (int e = 0; e < 4; ++e) o[e] = (v[j][e] * rstd * wv4[e]) * (1.f + sc[e]) + sh[e];
            u32x2 pk; pk.x = pk2(o[0], o[1]); pk.y = pk2(o[2], o[3]);
            *(u32x2*)(H + (size_t)row * DM + c) = pk; }
    }
}
__device__ __forceinline__ void ph_finalnorm(float* x, const float* w, int nrows) {
    const int lane = tid_opaque() & 63, wv = tid_opaque() >> 6;
    for (int row = blockIdx.x * 8 + wv; row < nrows; row += gridDim.x * 8) {
        float* src = x + (size_t)row * DM;
        f32x4 v[4]; float ss = 0.f;
#pragma unroll
        for (int j = 0; j < 4; ++j) { v[j] = *(const f32x4*)(src + (lane + 64 * j) * 4); ss += v[j][0] * v[j][0] + v[j][1] * v[j][1] + v[j][2] * v[j][2] + v[j][3] * v[j][3]; }
        const float rstd = rsqrtf(wave_sum(ss) * (1.f / DM) + EPS);
#pragma unroll
        for (int j = 0; j < 4; ++j) { const int c = (lane + 64 * j) * 4; const f32x4 wv4 = *(const f32x4*)(w + c);
            f32x4 o; for (int e = 0; e < 4; ++e) o[e] = v[j][e] * rstd * wv4[e];
            *(f32x4*)(src + c) = o; }
    }
}

template <class Epi> __device__ __forceinline__ void ph_gemm(unsigned char* lds, const pg8::Gemm& g, const Epi& E) {
    pg8::StaticOrder S; S.init(g.M, g.N, (int)gridDim.x, (int)blockIdx.x);
    pg8::gemm_phase<Epi, pg8::StaticOrder, true, true>((LAS unsigned char*)lds, g, S, E);
}

constexpr int LS = 72;
__device__ __forceinline__ int hg_row(int b, int dir, int cs, int i) {
    int q = cs * 64 + i;
    if (q < CTX) return MLAT + b * CTX + (dir ? CTX - 1 - q : q);
    q -= CTX; return b * SEQ + (dir ? SEQ - 1 - q : q);
}
__device__ __forceinline__ f32x4 mm_tile(const bf16_t* A, const bf16_t* Bt, int tm, int tn, int lane, f32x4 acc) {
    const int r = lane & 15, q = lane >> 4;
#pragma unroll
    for (int ks = 0; ks < 2; ++ks) {
        const bf16x8 a = *(const bf16x8*)(A + (tm * 16 + r) * LS + ks * 32 + q * 8), b = *(const bf16x8*)(Bt + (tn * 16 + r) * LS + ks * 32 + q * 8);
        acc = __builtin_amdgcn_mfma_f32_16x16x32_bf16(a, b, acc, 0, 0, 0);
    }
    return acc;
}
struct HgArgs { const bf16_t* QH; const bf16_t* VH; const bf16_t* OG; const float* GF; const float* GB; bf16_t* L; float* DC; bf16_t* MIX; const float* wn; const float* lb; };
__device__ __forceinline__ void ph_hgrn_h1(unsigned char* lds, const HgArgs& A, int nunits) {
    bf16_t* K2t = (bf16_t*)lds; bf16_t* Vt = K2t + 64 * LS; float (*part)[64] = (float (*)[64])(lds + 2 * 64 * LS * 2);
    const int tid = tid_opaque(), lane = tid & 63, wid = tid >> 6, d = tid & 63, p8 = tid >> 6;
    for (int unit = blockIdx.x; unit < nunits; unit += gridDim.x) {
        const int seq = unit / NCH, cs = unit % NCH, dir = seq & 1, bh = seq >> 1, b = bh >> 2, h = bh & 3;
        const float* G = dir ? A.GB : A.GF; const float lbv = A.lb[dir * 256 + h * 64 + d];
        float g[8], c[8]; int rows[8];
#pragma unroll
        for (int e = 0; e < 8; ++e) { rows[e] = hg_row(b, dir, cs, 8 * p8 + e); g[e] = log_forget(G[(size_t)rows[e] * 256 + h * 64 + d], lbv); }
        c[0] = g[0];
#pragma unroll
        for (int e = 1; e < 8; ++e) c[e] = c[e - 1] + g[e];
        __syncthreads();
        part[p8][d] = c[7];
        __syncthreads();
        float off = 0.f, tot = 0.f;
#pragma unroll
        for (int q = 0; q < 8; ++q) { const float x = part[q][d]; tot += x; if (q < p8) off += x; }
#pragma unroll
        for (int e = 0; e < 8; ++e) { const float cc = c[e] + off; const float k = -expm1f(g[e]); K2t[d * LS + 8 * p8 + e] = f2bf(k * __expf(tot - cc)); }
#pragma unroll
        for (int e = 0; e < 8; ++e) Vt[d * LS + 8 * p8 + e] = A.VH[(size_t)rows[e] * 256 + h * 64 + d];
        if (p8 == 0) A.DC[(size_t)unit * 64 + d] = __expf(tot);
        __syncthreads();
        const int tm = wid >> 1; bf16_t* Lp = A.L + (size_t)unit * 4096;
#pragma unroll
        for (int j = 0; j < 2; ++j) { const int tn = 2 * (wid & 1) + j; f32x4 acc = {0.f, 0.f, 0.f, 0.f};
            acc = mm_tile(Vt, K2t, tm, tn, lane, acc);
#pragma unroll
            for (int r = 0; r < 4; ++r) Lp[(tm * 16 + 4 * (lane >> 4) + r) * 64 + tn * 16 + (lane & 15)] = f2bf(acc[r]); }
    }
}
__device__ __forceinline__ void ph_hgrn_scan(bf16_t* L, const float* DC) {
    for (int idx = blockIdx.x * 512 + tid_opaque(); idx < 64 * 4096; idx += gridDim.x * 512) {
        const int seq = idx >> 12, e = idx & 4095, d = e & 63;
        float S = 0.f;
        for (int cs = 0; cs < NCH; ++cs) { const size_t o = ((size_t)seq * NCH + cs) * 4096 + e; const float lv = bf2f(L[o]); L[o] = f2bf(S); S = DC[((size_t)seq * NCH + cs) * 64 + d] * S + lv; }
    }
}
__device__ __forceinline__ void ph_hgrn_h3(unsigned char* lds, const HgArgs& A, int nlat, int nunits) {
    bf16_t* Q1 = (bf16_t*)lds; bf16_t* K1 = Q1 + 64 * LS; bf16_t* Q2 = K1 + 64 * LS; bf16_t* Vt = Q2 + 64 * LS; bf16_t* St = Vt + 64 * LS; bf16_t* Sm = St + 64 * LS;
    float (*part)[64] = (float (*)[64])(lds + 6 * 64 * LS * 2); float (*Ol)[65] = (float (*)[65])(lds + 6 * 64 * LS * 2 + 8 * 64 * 4);
    const int tid = tid_opaque(), lane = tid & 63, wid = tid >> 6, d = tid & 63, p8 = tid >> 6;
    for (int unit = blockIdx.x; unit < nunits; unit += gridDim.x) {
        int b, h, J; bool ctx;
        if (unit < nlat) { ctx = false; b = unit >> 7; h = (unit >> 5) & 3; J = unit & 31; } else { const int uc = unit - nlat; ctx = true; b = uc >> 4; h = (uc >> 2) & 3; J = uc & 3; }
        for (int dir = 0; dir < 2; ++dir) {
            const int cs = ctx ? (dir ? 3 - J : J) : (dir ? 4 + 31 - J : 4 + J);
            const int seq = (b * 4 + h) * 2 + dir; const float* G = dir ? A.GB : A.GF; const float lbv = A.lb[dir * 256 + h * 64 + d];
            float g[8], c[8]; int rows[8];
#pragma unroll
            for (int e = 0; e < 8; ++e) { rows[e] = hg_row(b, dir, cs, 8 * p8 + e); g[e] = log_forget(G[(size_t)rows[e] * 256 + h * 64 + d], lbv); }
            c[0] = g[0];
#pragma unroll
            for (int e = 1; e < 8; ++e) c[e] = c[e - 1] + g[e];
            __syncthreads();
            part[p8][d] = c[7];
            __syncthreads();
            float off = 0.f, R = 0.f;
#pragma unroll
            for (int q = 0; q < 8; ++q) { const float x = part[q][d]; if (q < 4) R += x; if (q < p8) off += x; }
            const bf16_t* Sp = A.L + ((size_t)seq * NCH + cs) * 4096;
#pragma unroll
            for (int e = 0; e < 8; ++e) { const int i = 8 * p8 + e; const float cc = c[e] + off, k = -expm1f(g[e]), q = bf2f(A.QH[(size_t)rows[e] * 256 + h * 64 + d]);
                Q1[i * LS + d] = f2bf(q * __expf(cc - R)); K1[i * LS + d] = f2bf(k * __expf(R - cc)); Q2[i * LS + d] = f2bf(q * __expf(cc));
                Vt[d * LS + i] = A.VH[(size_t)rows[e] * 256 + h * 64 + d];
                St[i * LS + d] = Sp[i * 64 + d]; }
            __syncthreads();
            const int tm = wid >> 1, q4 = lane >> 4, r16 = lane & 15;
#pragma unroll
            for (int j = 0; j < 2; ++j) { const int tn = 2 * (wid & 1) + j; f32x4 acc = {0.f, 0.f, 0.f, 0.f};
                acc = mm_tile(Q1, K1, tm, tn, lane, acc);
#pragma unroll
                for (int r = 0; r < 4; ++r) { const int t = tm * 16 + 4 * q4 + r, s = tn * 16 + r16; Sm[t * LS + s] = f2bf(s <= t ? acc[r] : 0.f); } }
            __syncthreads();
#pragma unroll
            for (int j = 0; j < 2; ++j) { const int tn = 2 * (wid & 1) + j; f32x4 acc = {0.f, 0.f, 0.f, 0.f};
                acc = mm_tile(Sm, Vt, tm, tn, lane, acc);
                acc = mm_tile(Q2, St, tm, tn, lane, acc);
#pragma unroll
                for (int r = 0; r < 4; ++r) { const int t = tm * 16 + 4 * q4 + r, v = tn * 16 + r16;
                    if (dir == 0) Ol[t][v] = acc[r]; else Ol[63 - t][v] += acc[r]; } }
            __syncthreads();
        }
        {
            const int tk = tid >> 3, v0 = (tid & 7) * 8; const int row = ctx ? MLAT + b * CTX + J * 64 + tk : b * SEQ + J * 64 + tk;
            float o[8], ss = 0.f;
#pragma unroll
            for (int e = 0; e < 8; ++e) { o[e] = Ol[tk][v0 + e]; ss += o[e] * o[e]; }
            ss += __shfl_xor(ss, 1); ss += __shfl_xor(ss, 2); ss += __shfl_xor(ss, 4);
            const float rstd = rsqrtf(ss * (1.f / 64.f) + EPS);
            const u32x4 ogw = *(const u32x4*)(A.OG + (size_t)row * 256 + h * 64 + v0);
            const unsigned og[4] = {ogw.x, ogw.y, ogw.z, ogw.w};
#pragma unroll
            for (int e = 0; e < 8; ++e) { const float gt = __uint_as_float((e & 1) ? (og[e >> 1] & 0xffff0000u) : (og[e >> 1] << 16)); o[e] = o[e] * rstd * A.wn[v0 + e] * gt; }
            store8_bf16(A.MIX + (size_t)row * DM + 512 + h * 64 + v0, o);
        }
    }
}

__device__ __forceinline__ void dftprep_unit(unsigned char* lds, const bf16_t* UU, int rowbase, int L, bf16_t* Bt, int unit) {
    float (*F)[256] = (float (*)[256])lds; float (*T)[64] = (float (*)[64])(lds + 32 * 256 * 4);
    const int tid = tid_opaque(), ntile = L / 32, b = unit / ntile, k0 = (unit % ntile) * 32, hL = L / 2;
    __syncthreads();
    if (tid < 64) { float s, c; sincospif((float)tid / 32.f, &s, &c); T[0][tid] = c * 0.125f; T[1][tid] = s * 0.125f; }
    for (int i = tid; i < 32 * 256; i += 512) { const int r = i >> 8, ch = i & 255, kk = k0 + r; const int k = kk <= hL ? kk : kk - hL;
        const float a = bf2f(UU[(size_t)(rowbase + b * L + k) * 256 + ch]);
        float f;
        if (k == 0 || k == hL) f = a; else { const float bb = bf2f(UU[(size_t)(rowbase + b * L + L - k) * 256 + ch]); f = kk <= hL ? a + bb : a - bb; }
        F[r][ch] = f; }
    __syncthreads();
    const int ch = tid >> 1, half = tid & 1, g = ch >> 6, cp = ch & 63;
    float o[16];
#pragma unroll
    for (int i = 0; i < 16; ++i) o[i] = 0.f;
    for (int c = 0; c < 64; ++c) { const int ph = (c * cp) & 63; const float tc = T[0][ph], ts = T[1][ph];
#pragma unroll
        for (int i = 0; i < 16; ++i) { const int r = 16 * half + i; o[i] += F[r][g * 64 + c] * ((k0 + r) <= hL ? tc : ts); } }
    bf16_t* op = Bt + (size_t)(b * 256 + ch) * L + k0 + 16 * half;
    store8_bf16(op, o); store8_bf16(op + 8, o + 8);
}

__device__ __forceinline__ void ph_convgate(const bf16_t* U, int nrows, int seqlen, const float* conv_w, const float* conv_b, bf16_t* G, int grow0) {
    for (int idx = blockIdx.x * 512 + tid_opaque(); idx < nrows * 352; idx += gridDim.x * 512) {
        const int r = idx / 352, j0 = (idx % 352) * 8;
        const int t = r % seqlen; const bool hp = t > 0, hn = t < seqlen - 1;
        const int cg = (j0 >> 7) * 256 + (j0 & 127), cv = cg + 128;
        float og[8];
        const bf16_t* up = U + (size_t)r * 5632;
        u32x4 z; z.x = z.y = z.z = z.w = 0u;
        const u32x4 g1 = *(const u32x4*)(up + cg), v1 = *(const u32x4*)(up + cv);
        const u32x4 g0 = hp ? *(const u32x4*)(up - 5632 + cg) : z, v0 = hp ? *(const u32x4*)(up - 5632 + cv) : z;
        const u32x4 g2 = hn ? *(const u32x4*)(up + 5632 + cg) : z, v2 = hn ? *(const u32x4*)(up + 5632 + cv) : z;
        const unsigned G0[4] = {g0.x, g0.y, g0.z, g0.w}, G1[4] = {g1.x, g1.y, g1.z, g1.w}, G2[4] = {g2.x, g2.y, g2.z, g2.w};
        const unsigned V0[4] = {v0.x, v0.y, v0.z, v0.w}, V1[4] = {v1.x, v1.y, v1.z, v1.w}, V2[4] = {v2.x, v2.y, v2.z, v2.w};
#pragma unroll
        for (int e = 0; e < 8; ++e) {
            const int jg = j0 + e, jv = DFF + j0 + e;
#define UNPK(W) __uint_as_float((e & 1) ? (W[e >> 1] & 0xffff0000u) : (W[e >> 1] << 16))
            const float a = conv_w[jg] * UNPK(G0) + conv_w[2 * DFF + jg] * UNPK(G1) + conv_w[4 * DFF + jg] * UNPK(G2) + conv_b[jg];
            const float c = conv_w[jv] * UNPK(V0) + conv_w[2 * DFF + jv] * UNPK(V1) + conv_w[4 * DFF + jv] * UNPK(V2) + conv_b[jv];
#undef UNPK
            og[e] = silu_f(a) * c;
        }
        store8_bf16(G + (size_t)(grow0 + r) * DFF + j0, og);
    }
}


extern __shared__ __attribute__((aligned(16))) unsigned char g_lds[];
constexpr int LDS_XB = pg8::STAGE_BYTES;
constexpr int LDS_EDGE = pg8::STAGE_BYTES + 256;
constexpr int LDS_BYTES = LDS_EDGE + 17 * 2 * 256 * 2;
constexpr int UP_LAT_TILES = NB * 9;
struct UpOrder : pg8::StaticOrder {
    __device__ __forceinline__ long a_off(int pm, size_t) const { const int row0 = pm < UP_LAT_TILES ? (pm / 9) * SEQ + 254 * (pm % 9) - 1 : MLAT + (pm - UP_LAT_TILES) * CTX; return (long)row0 * (DM * 2); }
};
__device__ __forceinline__ float dpp_shr1(float v) { return __builtin_bit_cast(float, __builtin_amdgcn_update_dpp(0, __builtin_bit_cast(int, v), 0x111, 0xf, 0xf, true)); }
__device__ __forceinline__ float dpp_shl1(float v) { return __builtin_bit_cast(float, __builtin_amdgcn_update_dpp(0, __builtin_bit_cast(int, v), 0x101, 0xf, 0xf, true)); }
struct EpiConvGate {
    static constexpr bool PERM = true, AFTER_DRAIN = false;
    bf16_t* G; const float* cw; const float* cb;
    __device__ __forceinline__ void operator()(const f32x4 (&acc)[2][2][4][2], const pg8::Unit& u, int wr, int wc, int fr, int fq) const {
        LAS unsigned char* eb = (LAS unsigned char*)g_lds + LDS_EDGE;
        int seqrow0, tbase, seqlen, rlo, rhi;
        if (u.pm < UP_LAT_TILES) { const int s = u.pm / 9, t = u.pm % 9; seqrow0 = s * SEQ; tbase = 254 * t - 1; seqlen = SEQ; rlo = 1; rhi = 254; }
        else { seqrow0 = MLAT + (u.pm - UP_LAT_TILES) * CTX; tbase = 0; seqlen = CTX; rlo = 0; rhi = 255; }
        const int colw = wc * 32 + fq * 8;
        unsigned ebo = (unsigned)((4 * wr * 2 * 256 + colw) * 2); asm volatile("" : "+v"(ebo));
        LAS unsigned char* const ebl = eb + ebo; LAS unsigned char* const ebw = ebl + (fr == 15 ? 512 : 0);
        if (fr == 0 || fr == 15) {
            const int which = fr == 15 ? 1 : 0;
#pragma unroll
            for (int ai = 0; ai < 2; ++ai)
#pragma unroll
                for (int m = 0; m < 4; ++m) {
#pragma unroll
                    for (int bj = 0; bj < 2; ++bj) { u32x4 w; w.x = pk2(acc[ai][bj][m][0][0], acc[ai][bj][m][0][1]); w.y = pk2(acc[ai][bj][m][0][2], acc[ai][bj][m][0][3]);
                        w.z = pk2(acc[ai][bj][m][1][0], acc[ai][bj][m][1][1]); w.w = pk2(acc[ai][bj][m][1][2], acc[ai][bj][m][1][3]);
                        *(LAS u32x4*)(ebw + ((8 * ai + m) * 2 * 256 + bj * 128) * 2) = w; } }
        }
        asm volatile("s_waitcnt lgkmcnt(0)" ::: "memory"); __builtin_amdgcn_s_barrier(); asm volatile("" ::: "memory");
#pragma unroll
        for (int n = 0; n < 2; ++n) {
            const int j = u.pn * 128 + colw + 4 * n;
            const f32x4 g0 = *(const f32x4*)(cw + j), g1 = *(const f32x4*)(cw + 2 * DFF + j), g2 = *(const f32x4*)(cw + 4 * DFF + j), gb = *(const f32x4*)(cb + j);
            const f32x4 v0 = *(const f32x4*)(cw + DFF + j), v1 = *(const f32x4*)(cw + 3 * DFF + j), v2 = *(const f32x4*)(cw + 5 * DFF + j), vb = *(const f32x4*)(cb + DFF + j);
#pragma unroll
            for (int ai = 0; ai < 2; ++ai)
#pragma unroll
                for (int m = 0; m < 4; ++m) {
                    const int blk = 8 * ai + 4 * wr + m, r = 16 * blk + fr, tpos = tbase + r;
                    constexpr int dummy = 0; (void)dummy; const int lb = 8 * ai + m;
                    const u32x2 pg = *(const LAS u32x2*)(ebl + (((lb - 1) * 2 + 1) * 256 + 4 * n) * 2), pv = *(const LAS u32x2*)(ebl + (((lb - 1) * 2 + 1) * 256 + 128 + 4 * n) * 2);
                    const u32x2 ng = *(const LAS u32x2*)(ebl + (((lb + 1) * 2 + 0) * 256 + 4 * n) * 2), nv = *(const LAS u32x2*)(ebl + (((lb + 1) * 2 + 0) * 256 + 128 + 4 * n) * 2);
                    const bool first = tpos == 0, lastp = tpos == seqlen - 1;
                    float o[4];
#pragma unroll
                    for (int e = 0; e < 4; ++e) {
                        const float cg = acc[ai][0][m][n][e], cv = acc[ai][1][m][n][e];
                        const unsigned wpg = e < 2 ? pg.x : pg.y, wpv = e < 2 ? pv.x : pv.y, wng = e < 2 ? ng.x : ng.y, wnv = e < 2 ? nv.x : nv.y;
                        const float epg = __uint_as_float((e & 1) ? (wpg & 0xffff0000u) : (wpg << 16)), epv = __uint_as_float((e & 1) ? (wpv & 0xffff0000u) : (wpv << 16));
                        const float eng = __uint_as_float((e & 1) ? (wng & 0xffff0000u) : (wng << 16)), env = __uint_as_float((e & 1) ? (wnv & 0xffff0000u) : (wnv << 16));
                        float sg = dpp_shr1(cg), sv = dpp_shr1(cv), lg = dpp_shl1(cg), lv = dpp_shl1(cv);
                        asm volatile("" : "+v"(sg), "+v"(sv), "+v"(lg), "+v"(lv));
                        float pgv = fr == 0 ? epg : sg, pvv = fr == 0 ? epv : sv;
                        float ngv = fr == 15 ? eng : lg, nvv = fr == 15 ? env : lv;
                        if (first) { pgv = 0.f; pvv = 0.f; }
                        if (lastp) { ngv = 0.f; nvv = 0.f; }
                        const float a = g0[e] * pgv + g1[e] * cg + g2[e] * ngv + gb[e];
                        const float c = v0[e] * pvv + v1[e] * cv + v2[e] * nvv + vb[e];
                        o[e] = silu_f(a) * c;
                    }
                    asm volatile("" : "+v"(o[0]), "+v"(o[1]), "+v"(o[2]), "+v"(o[3]));
                    if (r >= rlo && r <= rhi && tpos < seqlen) { u32x2 pk; pk.x = pk2(o[0], o[1]); pk.y = pk2(o[2], o[3]); *(u32x2*)(G + (size_t)(seqrow0 + tpos) * DFF + j) = pk; }
                    asm volatile("" ::: "memory");
                }
        }
    }
};

#define XB_TMO      128
#define XB_XCNT(j)  (256  + 64 * (j))
#define XB_XSUB(j)  (1280 + 64 * (j))
#define XB_XGEN(j)  (2304 + 64 * (j))
#define XB_TOP      3328
#define XB_TOPGEN   3392
#define XCD_BAR_WORDS 3456
#define XB_SPIN_CAP (1u << 18)

__device__ __forceinline__ unsigned xb_ld(unsigned* p)              { return __hip_atomic_load(p, __ATOMIC_RELAXED, __HIP_MEMORY_SCOPE_AGENT); }
__device__ __forceinline__ unsigned xb_add(unsigned* p, unsigned v) { return __hip_atomic_fetch_add(p, v, __ATOMIC_RELAXED, __HIP_MEMORY_SCOPE_AGENT); }
__device__ __forceinline__ unsigned xb_xcc_id() { return (unsigned)__builtin_amdgcn_s_getreg((3 << 11) | 20) & 0xFu; }
#define XB_SPIN(cond, bar) do { unsigned _sp = 0; while (cond) { __builtin_amdgcn_s_sleep(1); \
    if ((++_sp & 255u) == 0u) { if (xb_ld(&(bar)[XB_TMO])) break; if (_sp > XB_SPIN_CAP) { atomicAdd(&(bar)[XB_TMO], 1u); break; } } } } while (0)

struct XcdBarrier {
    unsigned* bar; unsigned x;
    volatile LAS unsigned* st;
};

__device__ __forceinline__ XcdBarrier xcd_barrier_post(unsigned* bar, volatile LAS unsigned* st) {
    XcdBarrier b; b.bar = bar; b.x = xb_xcc_id(); b.st = st;
    if (threadIdx.x == 0) (void)xb_add(&bar[XB_XCNT(b.x)], 1u);
    return b;
}
__device__ __forceinline__ void xcd_barrier_complete(unsigned* bar, unsigned x, unsigned& nloc, unsigned& nx) {
    const unsigned G = gridDim.x * gridDim.y * gridDim.z;
    unsigned sum, cnt, mine, sp = 0u;
    for (;;) {
        sum = 0u; cnt = 0u; mine = 0u;
#pragma unroll
        for (unsigned j = 0; j < 16; ++j) { const unsigned c = xb_ld(&bar[XB_XCNT(j)]); sum += c; cnt += (c > 0u) ? 1u : 0u; mine = (j == x) ? c : mine; }
        if (sum == G) break;
        __builtin_amdgcn_s_sleep(1);
        if ((++sp & 255u) == 0u) { if (xb_ld(&bar[XB_TMO])) break; if (sp > XB_SPIN_CAP) { atomicAdd(&bar[XB_TMO], 1u); break; } }
    }
    nloc = mine > 0u ? mine : 1u; nx = cnt > 0u ? cnt : 1u;
}

__device__ __forceinline__ void xcd_barrier(const XcdBarrier& b) {
    asm volatile("s_waitcnt vmcnt(0)" ::: "memory");
    __syncthreads();
    if (threadIdx.x == 0) {
        unsigned* bar = b.bar;
        __builtin_amdgcn_s_waitcnt(0);
        unsigned nloc = b.st[0], nx = b.st[1];
        if (nloc == 0u) { xcd_barrier_complete(bar, b.x, nloc, nx); b.st[0] = nloc; b.st[1] = nx; }
        const unsigned old = xb_add(&bar[XB_XSUB(b.x)], 1u);
        const unsigned gen = old / nloc;
        if (old + 1u == (gen + 1u) * nloc) {
            __builtin_amdgcn_fence(__ATOMIC_RELEASE, "agent");
            asm volatile("s_waitcnt vmcnt(0)" ::: "memory");
            const unsigned og = xb_add(&bar[XB_TOP], 1u);
            const unsigned tg = og / nx;
            if (og + 1u == (tg + 1u) * nx) xb_add(&bar[XB_TOPGEN], 1u);
            else XB_SPIN(xb_ld(&bar[XB_TOPGEN]) == tg, bar);
            __builtin_amdgcn_fence(__ATOMIC_ACQUIRE, "agent");
            xb_add(&bar[XB_XGEN(b.x)], 1u);
            asm volatile("s_waitcnt vmcnt(0)" ::: "memory");
        } else {
            XB_SPIN(xb_ld(&bar[XB_XGEN(b.x)]) == gen, bar);
            __builtin_amdgcn_fence(__ATOMIC_ACQUIRE, "agent");
            asm volatile("s_waitcnt vmcnt(0)" ::: "memory");
        }
    }
    __syncthreads();
}

#define REP_PRO 1
#define REP_NORM 1
#define REP_INPROJ 1
#define REP_A1 1
#define REP_H1 1
#define REP_PREP 1
#define REP_A2 1
#define REP_DFT 1
#define REP_H3 1
#define REP_UP 1
#define REP_CG 1
#define REP_SYNC 1
namespace cg = cooperative_groups;

__global__ void __launch_bounds__(512, 2) mega_fwd(P p) {
    unsigned char* const lds = g_lds;
    cg::grid_group grid = cg::this_grid();
    float* out = p.out;
    float* MOD = WSP(float, WS_MOD); float* LAM = WSP(float, WS_LAM); float* LB = WSP(float, WS_LB); float* ROPE = WSP(float, WS_ROPE); float* STATS = WSP(float, WS_STATS);
    bf16_t* WIN = WSP(bf16_t, WS_WIN); bf16_t* WOUT = WSP(bf16_t, WS_WOUT); bf16_t* WUP = WSP(bf16_t, WS_WUP); bf16_t* WDOWN = WSP(bf16_t, WS_WDOWN);
    bf16_t* DFT = WSP(bf16_t, WS_DFT); bf16_t* DFTC = WSP(bf16_t, WS_DFTC); float* CTXX = WSP(float, WS_CTXX); bf16_t* H = WSP(bf16_t, WS_H); bf16_t* MIX = H;
    bf16_t* QA = WSP(bf16_t, WS_QA); bf16_t* KC = WSP(bf16_t, WS_KC); bf16_t* VT = WSP(bf16_t, WS_VT); bf16_t* QH = WSP(bf16_t, WS_QH); bf16_t* VH = WSP(bf16_t, WS_VH);
    bf16_t* OG = WSP(bf16_t, WS_OG); bf16_t* UU = WSP(bf16_t, WS_UU); float* GF = WSP(float, WS_GF); float* GB = WSP(float, WS_GB);
    bf16_t* LBUF = WSP(bf16_t, WS_L); float* DC = WSP(float, WS_DC); bf16_t* BT = WSP(bf16_t, WS_BT); bf16_t* BTC = WSP(bf16_t, WS_BTC);
    bf16_t* GBUF = WSP(bf16_t, WS_G); bf16_t* UCH = WSP(bf16_t, WS_UCH);
    const int G = gridDim.x, bid = blockIdx.x;
    if (tid_opaque() < 64) ((LAS unsigned*)(lds + LDS_XB))[tid_opaque()] = 0u;
    __syncthreads();
    const XcdBarrier bar = xcd_barrier_post(WSP(unsigned, WS_CTL), (volatile LAS unsigned*)(lds + LDS_XB));

    for (int rep = 0; rep < REP_PRO; ++rep) ph_prologue(p, lds);
    grid.sync();
    for (int li = 0; li < 2; ++li) {
        const bool last = li == 1; const float* mod = MOD + (size_t)li * 9 * 6144;
        const float* xl = li == 0 ? p.x : (const float*)out; const float* xc = li == 0 ? p.ctx : (const float*)CTXX;
        for (int rep = 0; rep < REP_NORM; ++rep) ph_normmod(xl, xc, p.norm1_w + li * DM, mod, H, 0, MTOT);
        if (li == 1) for (int u = bid; u < TU_WUP + TU_WDOWN; u += G) ffn_weight_units(p, lds, 1, u);
        xcd_barrier(bar);
        { pg8::Gemm g{H, WIN + (size_t)li * PW * DM, MTOT, PW, DM, 0}; EpiInProj E{QA, KC, VT, QH, VH, OG, UU, GF, GB, ROPE, LB + li * 512}; for (int rep = 0; rep < REP_INPROJ; ++rep) ph_gemm(lds, g, E); }
        xcd_barrier(bar);
        const AttnArgs AA{QA, KC, VT, STATS, MIX, LAM + li, p.subln_w + li * 128, 256, last ? 256 : 288};
        const HgArgs HA{QH, VH, OG, GF, GB, LBUF, DC, MIX, p.hgrn_norm_w + li * 64, LB + li * 512};
        for (int rep = 0; rep < REP_A1; ++rep) for (int u = bid; u < AA.nunits; u += G) attn_unit<1>(lds, AA, u);
        __syncthreads();
        for (int rep = 0; rep < REP_H1; ++rep) ph_hgrn_h1(lds, HA, 64 * NCH);
        for (int rep = 0; rep < REP_PREP; ++rep) for (int u = bid; u < NB * SEQ / 32; u += G) dftprep_unit(lds, UU, 0, SEQ, BT, u);
        if (!last) for (int u = bid; u < NB * CTX / 32; u += G) dftprep_unit(lds, UU, MLAT, CTX, BTC, u);
        xcd_barrier(bar);
        for (int rep = 0; rep < REP_A2; ++rep) for (int u = bid; u < AA.nunits; u += G) attn_unit<2>(lds, AA, u);
        ph_hgrn_scan(LBUF, DC);
        __syncthreads();
        { pg8::Gemm g{DFT, BT, SEQ, NB * 256, SEQ, 0}; EpiDft E{MIX, 0, SEQ}; for (int rep = 0; rep < REP_DFT; ++rep) ph_gemm(lds, g, E); }
        if (!last) { pg8::Gemm g{DFTC, BTC, CTX, NB * 256, CTX, 0}; EpiDft E{MIX, MLAT, CTX}; ph_gemm(lds, g, E); }
        xcd_barrier(bar);
        for (int rep = 0; rep < REP_H3; ++rep) ph_hgrn_h3(lds, HA, 1024, last ? 1024 : 1024 + 128);
        for (int rep = 0; rep < REP_SYNC; ++rep) xcd_barrier(bar);
        const int Mff = last ? MLAT : MTOT;
        { pg8::Gemm g{MIX, WOUT + (size_t)li * DM * DM, Mff, DM, DM, 0}; EpiResid E{xl, xc, out, CTXX, mod, 2048, 0}; ph_gemm(lds, g, E); }
        xcd_barrier(bar);
        ph_normmod(out, CTXX, p.norm2_w + li * DM, mod, H, 3072, Mff);
        xcd_barrier(bar);
        { const int ntile = last ? UP_LAT_TILES : UP_LAT_TILES + NB;
          pg8::Gemm g{H, WUP, ntile * 256, 2 * DFF, DM, 0}; EpiConvGate E{GBUF, p.conv_w + (size_t)li * 3 * 2 * DFF, p.conv_b + (size_t)li * 2 * DFF};
          UpOrder S; S.init(g.M, g.N, G, bid);
          for (int rep = 0; rep < REP_UP; ++rep) pg8::gemm_phase<EpiConvGate, UpOrder, true, true>((LAS unsigned char*)lds, g, S, E); }
        xcd_barrier(bar);
        { pg8::Gemm g{GBUF, WDOWN, Mff, DM, DFF, 0}; EpiResid E{out, CTXX, out, CTXX, mod, 5120, 0}; ph_gemm(lds, g, E); }
        xcd_barrier(bar);
    }
    ph_finalnorm(out, p.final_norm_w, MLAT);
}

extern "C" void kernel_launch(void* const* d_in, const int* in_sizes, int n_in, void* d_out, int out_size, void* d_ws, size_t ws_size, hipStream_t stream) {
    static int grid = 0;
    if (grid == 0) {
        if (n_in != 20 || ws_size < WS_END || out_size != MLAT * DM) { fprintf(stderr, "kernel_launch: unexpected sizes (n_in %d, ws %zu, out %d)\n", n_in, ws_size, out_size); grid = -1; return; }
        int dev = 0, cus = 0, per_cu = 0;
        (void)hipGetDevice(&dev); (void)hipDeviceGetAttribute(&cus, hipDeviceAttributeMultiprocessorCount, dev);
        (void)hipFuncSetAttribute((const void*)mega_fwd, hipFuncAttributeMaxDynamicSharedMemorySize, LDS_BYTES);
        if (hipOccupancyMaxActiveBlocksPerMultiprocessor(&per_cu, (const void*)mega_fwd, 512, LDS_BYTES) != hipSuccess || per_cu < 1) { fprintf(stderr, "kernel_launch: occupancy query failed (%d)\n", per_cu); per_cu = 1; }
        (void)hipGetLastError();
        if (per_cu > 1) per_cu = 1;
        grid = cus * per_cu;
    }
    if (grid < 0) return;
    if (hipMemsetAsync(d_ws, 0, 64 * 1024, stream) != hipSuccess) { fprintf(stderr, "kernel_launch: hipMemsetAsync failed\n"); return; }
    P p{};
    const float** pp = (const float**)&p;
    for (int i = 0; i < 20; ++i) pp[i] = (const float*)d_in[i];
    p.out = (float*)d_out; p.ws = (unsigned char*)d_ws;
    void* args[] = {&p};
    hipError_t e = hipLaunchCooperativeKernel((const void*)mega_fwd, dim3(grid), dim3(512), args, LDS_BYTES, stream);
    if (e != hipSuccess) fprintf(stderr, "kernel_launch: cooperative launch failed: %s (grid %d)\n", hipGetErrorString(e), grid);
}
```

```cpp
#include <hip/hip_runtime.h>
#include <hip/hip_cooperative_groups.h>
#include <cstdio>
#include <cstdint>
__device__ __forceinline__ int tid_opaque() { int t = threadIdx.x; asm volatile("" : "+v"(t)); return t; }
namespace pg8 {
#define PG8_LAS __attribute__((address_space(3)))
typedef unsigned short bf16_t;
typedef short bf16x8 __attribute__((ext_vector_type(8)));
typedef float f32x4 __attribute__((ext_vector_type(4)));
typedef unsigned u32x4 __attribute__((ext_vector_type(4)));
constexpr int BM = 256, BK = 64, HALF = 128, HTB = HALF * BK * 2  , STAGE_BYTES = 8 * HTB, NXCD = 8, WGM = 8;

__host__ __device__ __forceinline__ int lds_byte(int r, int c) { const int st = (r >> 4) * 2 + (c >> 5), rr = r & 15, cc = c & 31, ob = rr * 64 + cc * 2; return st * 1024 + (ob ^ (((ob >> 9) & 1) << 5)); }
__host__ __device__ __forceinline__ void stage_rc(int b, int& R, int& C) { const int st = b / 1024, sb = b % 1024, swz = sb ^ (((sb >> 9) & 1) << 5); R = (st >> 1) * 16 + swz / 64; C = (st & 1) * 32 + (swz % 64) / 2; }
__host__ __device__ __forceinline__ int perm32(int rho) { const int n = rho >> 4, i = rho & 15; return 8 * (i >> 2) + 4 * n + (i & 3); }

struct Unit { int pm, pn; };
struct Gemm { const bf16_t* A; const bf16_t* Bt; int M, N, K, pad; };

struct StaticOrder {
    int nM, nN, nwg, G, c;
    __host__ __device__ void init(int M, int N, int G_, int c_) { nM = M / BM; nN = N / BM; nwg = nM * nN; G = G_; c = c_; }
    __host__ __device__ bool next(int i, Unit& u) const {
        const long L = (long)i * G + c; if (L >= nwg) return false;
        int wgid = (int)L; { const int q = nwg / NXCD, r = nwg % NXCD, xcd = wgid % NXCD, off = wgid / NXCD; wgid = (xcd < r ? xcd * (q + 1) : r * (q + 1) + (xcd - r) * q) + off; }
        const int nig = WGM * nN, gid = wgid / nig, fm = gid * WGM, gsz = (nM - fm) < WGM ? (nM - fm) : WGM;
        u.pm = fm + ((wgid % nig) % gsz); u.pn = (wgid % nig) / gsz; return true;
    }
    __device__ __forceinline__ long a_off(int pm, size_t tstep) const { return (long)pm * (long)tstep; }
    __device__ __forceinline__ void a_ready(const Unit&) const {}
    __device__ __forceinline__ void done(const Unit&) const {}
};

template <class Epi, class Sched, bool ALIGN_EPI = false, bool SP2 = false>
__device__ __forceinline__ void gemm_phase(PG8_LAS unsigned char* lds, const Gemm g, const Sched& S, const Epi& E) {
    const int tid = tid_opaque(), wid = __builtin_amdgcn_readfirstlane(tid >> 6), lane = tid & 63, wr = wid >> 2, wc = wid & 3, fr = lane & 15, fq = lane >> 4;
    const int K = g.K, nt = K / BK;
    unsigned voffA[2], voffB[2];
#pragma unroll
    for (int i = 0; i < 2; ++i) { int R, C; stage_rc(tid * 16 + i * 8192, R, C); const int Rb = Epi::PERM ? ((R & ~31) + perm32(R & 31)) : R;
        voffA[i] = (unsigned)(R * K + C) * 2u; voffB[i] = (unsigned)(Rb * K + C) * 2u; }
    const size_t kstep = (size_t)(BK * 2);
    const size_t hstep = (size_t)HALF * K * 2;
    const size_t tstep = 2 * hstep;
    const unsigned ldsw = (unsigned)wid * 1024u;
    const int aoff = lds_byte(wr * 64 + fr, fq * 8), boff = lds_byte(wc * 32 + fr, fq * 8);
#define PG8_SA(b, h) (((b) * 2 + (h)) * HTB)
#define PG8_SB(b, h) ((4 + (b) * 2 + (h)) * HTB)
#define PG8_STAGE(bufoff, gbase, voff) do { _Pragma("unroll") for (int _i = 0; _i < 2; ++_i) \
        __builtin_amdgcn_global_load_lds((const unsigned*)((const char*)(gbase) + (voff)[_i]), (PG8_LAS unsigned*)(lds + (bufoff) + ldsw + _i * 8192), 16, 0, 0); } while (0)
#define PG8_LDA(dst, b, h) do { _Pragma("unroll") for (int m = 0; m < 4; ++m) _Pragma("unroll") for (int k = 0; k < 2; ++k) dst[m][k] = *(const PG8_LAS bf16x8*)(lds + PG8_SA(b, h) + aoff + m * 2048 + k * 1024); } while (0)
#define PG8_LDB(dst, b, h) do { _Pragma("unroll") for (int n = 0; n < 2; ++n) _Pragma("unroll") for (int k = 0; k < 2; ++k) dst[n][k] = *(const PG8_LAS bf16x8*)(lds + PG8_SB(b, h) + boff + n * 2048 + k * 1024); } while (0)
#define PG8_MMA(ai, bj, At, Bt) do { __builtin_amdgcn_s_setprio(1); _Pragma("unroll") for (int m = 0; m < 4; ++m) _Pragma("unroll") for (int n = 0; n < 2; ++n) _Pragma("unroll") for (int k = 0; k < 2; ++k) \
        acc[ai][bj][m][n] = __builtin_amdgcn_mfma_f32_16x16x32_bf16(Bt[n][k], At[m][k], acc[ai][bj][m][n], 0, 0, 0); __builtin_amdgcn_s_setprio(0); } while (0)
#define PG8_WAIT_V(n) asm volatile("s_waitcnt vmcnt(" #n ")" ::: "memory")
#define PG8_WAIT_L(n) asm volatile("s_waitcnt lgkmcnt(" #n ")" ::: "memory")
#define PG8_BAR __builtin_amdgcn_s_barrier()
#define PG8_SCHED __builtin_amdgcn_sched_barrier(0)
    Unit cur, nxt; int ui = 0;
    if (!S.next(0, cur)) return;
    f32x4 acc[2][2][4][2];
#pragma unroll
    for (int a = 0; a < 2; ++a)
#pragma unroll
        for (int b = 0; b < 2; ++b)
#pragma unroll
            for (int m = 0; m < 4; ++m)
#pragma unroll
                for (int n = 0; n < 2; ++n) acc[a][b][m][n] = (f32x4){0.f, 0.f, 0.f, 0.f};
    bf16x8 At[4][2], B0[2][2], B1[2][2];
    const char* cA = (const char*)g.A + S.a_off(cur.pm, tstep); const char* cB = (const char*)g.Bt + (size_t)cur.pn * tstep;
    S.a_ready(cur);
    if constexpr (SP2) {
        PG8_STAGE(PG8_SB(0, 0), cB, voffB); PG8_STAGE(PG8_SB(0, 1), cB + hstep, voffB); PG8_STAGE(PG8_SA(0, 0), cA, voffA); PG8_STAGE(PG8_SA(0, 1), cA + hstep, voffA);
        if (wr == 1) PG8_BAR;
        PG8_WAIT_V(2); PG8_BAR;
        PG8_STAGE(PG8_SB(1, 0), cB + kstep, voffB); PG8_STAGE(PG8_SA(1, 0), cA + kstep, voffA); PG8_STAGE(PG8_SB(1, 1), cB + hstep + kstep, voffB);
        PG8_WAIT_V(6); PG8_BAR;
    } else {
        PG8_STAGE(PG8_SB(0, 0), cB, voffB); PG8_STAGE(PG8_SA(0, 0), cA, voffA); PG8_STAGE(PG8_SB(0, 1), cB + hstep, voffB); PG8_STAGE(PG8_SA(0, 1), cA + hstep, voffA);
        if (wr == 1) PG8_BAR;
        PG8_WAIT_V(4); PG8_BAR;
        PG8_STAGE(PG8_SB(1, 0), cB + kstep, voffB); PG8_STAGE(PG8_SA(1, 0), cA + kstep, voffA); PG8_STAGE(PG8_SB(1, 1), cB + hstep + kstep, voffB);
        PG8_WAIT_V(6); PG8_BAR;
    }
    for (;;) {
        const bool has_next = S.next(ui + 1, nxt);
        const char* nA = has_next ? (const char*)g.A + S.a_off(nxt.pm, tstep) : cA; const char* nB = has_next ? (const char*)g.Bt + (size_t)nxt.pn * tstep : cB;
        for (int t = 0; t < nt; t += 2) {
            const bool last = (t == nt - 2);
            const char* a1 = cA + (size_t)(t + 1) * kstep;
            const char* a2 = last ? nA : cA + (size_t)(t + 2) * kstep; const char* b2 = last ? nB : cB + (size_t)(t + 2) * kstep;
            const char* a3 = a2 + kstep; const char* b3 = b2 + kstep;
            if (last && has_next) S.a_ready(nxt);
            if constexpr (SP2) {
            PG8_LDB(B0, 0, 0); PG8_LDB(B1, 0, 1); PG8_SCHED; PG8_LDA(At, 0, 0); PG8_STAGE(PG8_SA(1, 1), a1 + hstep, voffA);
            PG8_WAIT_V(8); PG8_WAIT_L(0); PG8_BAR; PG8_MMA(0, 0, At, B0); PG8_MMA(0, 1, At, B1); PG8_BAR; PG8_SCHED;
            PG8_LDA(At, 0, 1); PG8_STAGE(PG8_SB(0, 0), b2, voffB); PG8_STAGE(PG8_SB(0, 1), b2 + hstep, voffB); PG8_STAGE(PG8_SA(0, 0), a2, voffA);
            PG8_WAIT_V(8); PG8_WAIT_L(0); PG8_BAR; PG8_MMA(1, 0, At, B0); PG8_MMA(1, 1, At, B1); PG8_BAR; PG8_SCHED;
            PG8_LDB(B0, 1, 0); PG8_LDB(B1, 1, 1); PG8_SCHED; PG8_LDA(At, 1, 0); PG8_STAGE(PG8_SA(0, 1), a2 + hstep, voffA);
            PG8_WAIT_V(8); PG8_WAIT_L(0); PG8_BAR; PG8_MMA(0, 0, At, B0); PG8_MMA(0, 1, At, B1); PG8_BAR; PG8_SCHED;
            PG8_LDA(At, 1, 1); PG8_STAGE(PG8_SB(1, 0), b3, voffB); PG8_STAGE(PG8_SB(1, 1), b3 + hstep, voffB); PG8_STAGE(PG8_SA(1, 0), a3, voffA);
            PG8_WAIT_V(8); PG8_WAIT_L(0); PG8_BAR; PG8_MMA(1, 0, At, B0); PG8_MMA(1, 1, At, B1); PG8_BAR; PG8_SCHED;
            } else {
            PG8_LDB(B0, 0, 0); PG8_SCHED; PG8_LDA(At, 0, 0); PG8_STAGE(PG8_SA(1, 1), a1 + hstep, voffA);
            PG8_WAIT_L(8); PG8_BAR; PG8_WAIT_L(0); PG8_MMA(0, 0, At, B0); PG8_BAR; PG8_SCHED;
            PG8_LDB(B1, 0, 1); PG8_STAGE(PG8_SB(0, 0), b2, voffB);
            PG8_BAR; PG8_WAIT_L(0); PG8_MMA(0, 1, At, B1); PG8_BAR;
            PG8_LDA(At, 0, 1); PG8_STAGE(PG8_SA(0, 0), a2, voffA);
            PG8_BAR; PG8_WAIT_L(0); PG8_MMA(1, 0, At, B0); PG8_BAR; PG8_SCHED;
            PG8_STAGE(PG8_SB(0, 1), b2 + hstep, voffB);
            PG8_WAIT_V(6); PG8_BAR; PG8_MMA(1, 1, At, B1); PG8_BAR;
            PG8_LDB(B0, 1, 0); PG8_SCHED; PG8_LDA(At, 1, 0); PG8_STAGE(PG8_SA(0, 1), a2 + hstep, voffA);
            PG8_WAIT_L(8); PG8_BAR; PG8_WAIT_L(0); PG8_MMA(0, 0, At, B0); PG8_BAR; PG8_SCHED;
            PG8_LDB(B1, 1, 1); PG8_STAGE(PG8_SB(1, 0), b3, voffB);
            PG8_BAR; PG8_WAIT_L(0); PG8_MMA(0, 1, At, B1); PG8_BAR;
            PG8_LDA(At, 1, 1); PG8_STAGE(PG8_SA(1, 0), a3, voffA);
            PG8_BAR; PG8_WAIT_L(0); PG8_MMA(1, 0, At, B0); PG8_BAR; PG8_SCHED;
            PG8_STAGE(PG8_SB(1, 1), b3 + hstep, voffB);
            PG8_WAIT_V(6); PG8_BAR; PG8_MMA(1, 1, At, B1); PG8_BAR;
            }
        }
        if constexpr (ALIGN_EPI) { if (wr == 0) PG8_BAR; }
        if constexpr (!Epi::AFTER_DRAIN) { E(acc, cur, wr, wc, fr, fq); S.done(cur); }
        if (!has_next) break;
#pragma unroll
        for (int a = 0; a < 2; ++a)
#pragma unroll
            for (int b = 0; b < 2; ++b)
#pragma unroll
                for (int m = 0; m < 4; ++m)
#pragma unroll
                    for (int n = 0; n < 2; ++n) acc[a][b][m][n] = (f32x4){0.f, 0.f, 0.f, 0.f};
        cur = nxt; cA = nA; cB = nB; ++ui;
        if constexpr (ALIGN_EPI) { if (wr == 1) PG8_BAR; }
    }
    PG8_WAIT_V(0);
    if constexpr (!ALIGN_EPI) { if (wr == 0) PG8_BAR; }
    PG8_BAR;
    if constexpr (Epi::AFTER_DRAIN) { E.fused(acc, cur, wr, wc, fr, fq, lds, wid, lane); S.done(cur); }
#undef PG8_SA
#undef PG8_SB
#undef PG8_STAGE
#undef PG8_LDA
#undef PG8_LDB
#undef PG8_MMA
#undef PG8_WAIT_V
#undef PG8_WAIT_L
#undef PG8_BAR
#undef PG8_SCHED
}
}

using pg8::bf16_t; using pg8::bf16x8; using pg8::f32x4;
typedef float f32x16 __attribute__((ext_vector_type(16)));
typedef short s16x4 __attribute__((ext_vector_type(4)));
typedef unsigned u32x4 __attribute__((ext_vector_type(4)));
typedef unsigned u32x2 __attribute__((ext_vector_type(2)));
#define LAS __attribute__((address_space(3)))

constexpr int DM = 1024, NB = 8, SEQ = 2048, CTX = 256, MLAT = NB * SEQ, MCTX = NB * CTX, MTOT = MLAT + MCTX;
constexpr int PW = 3072, DFF = 2816, KEYS = SEQ + CTX, NCH = 36  ;
constexpr float EPS = 1e-6f;
constexpr float QSCALE = 0.125f * 1.4426950408889634f;

constexpr size_t MiB = 1u << 20;
constexpr size_t WS_CTL = 0;
constexpr size_t WS_MOD = 64 * 1024;
constexpr size_t WS_LAM = 512 * 1024;
constexpr size_t WS_LB = WS_LAM + 256;
constexpr size_t WS_ROPE = WS_LB + 4096;
constexpr size_t WS_STATS = 1 * MiB;
constexpr size_t WS_WIN = 4 * MiB;
constexpr size_t WS_WOUT = 16 * MiB;
constexpr size_t WS_WUP = 21 * MiB;
constexpr size_t WS_WDOWN = 32 * MiB;
constexpr size_t WS_DFT = 38 * MiB;
constexpr size_t WS_DFTC = 46 * MiB;
constexpr size_t WS_CTXX = 47 * MiB;
constexpr size_t WS_H = 55 * MiB;
constexpr size_t WS_QA = 91 * MiB;
constexpr size_t WS_KC = 109 * MiB;
constexpr size_t WS_VT = 127 * MiB;
constexpr size_t WS_QH = 145 * MiB;
constexpr size_t WS_VH = 154 * MiB;
constexpr size_t WS_OG = 163 * MiB;
constexpr size_t WS_UU = 172 * MiB;
constexpr size_t WS_GF = 181 * MiB;
constexpr size_t WS_GB = 199 * MiB;
constexpr size_t WS_L = 217 * MiB;
constexpr size_t WS_DC = 235 * MiB;
constexpr size_t WS_BT = 236 * MiB;
constexpr size_t WS_BTC = 244 * MiB;
constexpr size_t WS_FOLD = 245 * MiB;
constexpr size_t WS_G = 91 * MiB;
constexpr size_t WS_UCH = 190 * MiB;
constexpr size_t WS_END = 248 * MiB;

__device__ __forceinline__ bf16_t f2bf(float f) { unsigned u = __float_as_uint(f); return (bf16_t)((u + 0x7fffu + ((u >> 16) & 1u)) >> 16); }
__device__ __forceinline__ float bf2f(bf16_t h) { return __uint_as_float(((unsigned)h) << 16); }
typedef float f32x2_t __attribute__((ext_vector_type(2))); typedef __bf16 bf16x2_t __attribute__((ext_vector_type(2)));
__device__ __forceinline__ unsigned pk2(float lo, float hi) { f32x2_t v = {lo, hi}; bf16x2_t b = __builtin_convertvector(v, bf16x2_t); return __builtin_bit_cast(unsigned, b); }
__device__ __forceinline__ float silu_f(float v) { return v / (1.f + __expf(-v)); }
__device__ __forceinline__ float wave_sum(float v) {
#pragma unroll
    for (int o = 1; o < 64; o <<= 1) v += __shfl_xor(v, o);
    return v;
}

template <class F> __device__ __forceinline__ void epi_for_each(const f32x4 (&acc)[2][2][4][2], const pg8::Unit& u, int wr, int wc, int fr, int fq, F f) {
#pragma unroll
    for (int ai = 0; ai < 2; ++ai)
#pragma unroll
        for (int m = 0; m < 4; ++m) { const int row = u.pm * 256 + ai * 128 + wr * 64 + m * 16 + fr;
#pragma unroll
            for (int bj = 0; bj < 2; ++bj) { const int col = u.pn * 256 + bj * 128 + wc * 32 + fq * 8;
                float v[8];
#pragma unroll
                for (int e = 0; e < 4; ++e) { v[e] = acc[ai][bj][m][0][e]; v[4 + e] = acc[ai][bj][m][1][e]; }
                f(row, col, v); } }
}
__device__ __forceinline__ void store8_bf16(bf16_t* p, const float* v) { u32x4 w; w.x = pk2(v[0], v[1]); w.y = pk2(v[2], v[3]); w.z = pk2(v[4], v[5]); w.w = pk2(v[6], v[7]); *(u32x4*)p = w; }

struct EpiStoreBf16 {
    static constexpr bool PERM = true, AFTER_DRAIN = false;
    bf16_t* O; int ldc, pad;
    __device__ __forceinline__ void operator()(const f32x4 (&acc)[2][2][4][2], const pg8::Unit& u, int wr, int wc, int fr, int fq) const {
        epi_for_each(acc, u, wr, wc, fr, fq, [&](int row, int col, float* v) __attribute__((always_inline)) { store8_bf16(O + (size_t)row * ldc + col, v); });
    }
};
struct EpiDft {
    static constexpr bool PERM = true, AFTER_DRAIN = false;
    bf16_t* MIX; int rowbase, L;
    __device__ __forceinline__ void operator()(const f32x4 (&acc)[2][2][4][2], const pg8::Unit& u, int wr, int wc, int fr, int fq) const {
        epi_for_each(acc, u, wr, wc, fr, fq, [&](int row, int col, float* v) __attribute__((always_inline)) { const int b = col >> 8, ch = col & 255; store8_bf16(MIX + (size_t)(rowbase + b * L + row) * DM + 768 + ch, v); });
    }
};
struct EpiResid {
    static constexpr bool PERM = true, AFTER_DRAIN = false;
    const float* xin_lat; const float* xin_ctx; float* xout_lat; float* xout_ctx; const float* mod; int goff, pad;
    __device__ __forceinline__ void operator()(const f32x4 (&acc)[2][2][4][2], const pg8::Unit& u, int wr, int wc, int fr, int fq) const {
        const bool ctx = u.pm >= 64; const float* gv = mod + (size_t)(ctx ? 8 : (u.pm >> 3)) * 6144 + goff;
        const float* xi = ctx ? xin_ctx - (size_t)MLAT * DM : xin_lat; float* xo = ctx ? xout_ctx - (size_t)MLAT * DM : xout_lat;
        epi_for_each(acc, u, wr, wc, fr, fq, [&](int row, int col, float* v) __attribute__((always_inline)) {
            const size_t off = (size_t)row * DM + col; const f32x4 g0 = *(const f32x4*)(gv + col), g1 = *(const f32x4*)(gv + col + 4);
            const f32x4 x0 = *(const f32x4*)(xi + off), x1 = *(const f32x4*)(xi + off + 4); f32x4 o0, o1;
            for (int e = 0; e < 4; ++e) { o0[e] = x0[e] + g0[e] * v[e]; o1[e] = x1[e] + g1[e] * v[4 + e]; }
            *(f32x4*)(xo + off) = o0; *(f32x4*)(xo + off + 4) = o1; });
    }
};
__device__ __forceinline__ float log_forget(float z, float lb) {
    const float e = __expf(-fabsf(z)), r = __builtin_amdgcn_rcpf(1.f + e);
    if (lb <= 0.f) { const float l1p = e < 0.01f ? e * (1.f - e * (0.5f - e * 0.33333333f)) : __logf(1.f + e); return fminf(z, 0.f) - l1p; }
    const float k = (1.f - lb) * (z >= 0.f ? e * r : r);
    return k < 0.01f ? -k * (1.f + k * (0.5f + k * 0.33333333f)) : __logf(1.f - k);
}
struct EpiInProj {
    static constexpr bool PERM = true, AFTER_DRAIN = false;
    bf16_t *QA, *KC, *VT, *QH, *VH, *OG, *UU; float *GF, *GB; const float* rope; const float* lb;
    __device__ __forceinline__ void operator()(const f32x4 (&acc)[2][2][4][2], const pg8::Unit& u, int wr, int wc, int fr, int fq) const {
        const int pn = u.pn; const bool ctx = u.pm >= 64;
        if (pn < 4) {
            epi_for_each(acc, u, wr, wc, fr, fq, [&](int row, int col, float* v) __attribute__((always_inline)) {
                int b, t; if (ctx) { const int rc = row - MLAT; b = rc >> 8; t = rc & 255; } else { b = row >> 11; t = row & 2047; }
                if (!ctx) {
                    const int cl = col & 63, gi = cl >> 5, i0 = cl & 31, j0 = i0 & 15; const bool second = i0 >= 16;
                    const int pos = gi ? (t & 63) : (t >> 6);
                    const float* ct = rope + pos * 16 + j0; const f32x4 c0 = *(const f32x4*)ct, c1 = *(const f32x4*)(ct + 4), s0 = *(const f32x4*)(ct + 1024), s1 = *(const f32x4*)(ct + 1028);
#pragma unroll
                    for (int e = 0; e < 8; ++e) { const float pr = __shfl_xor(v[e], 32); const float cs = e < 4 ? c0[e & 3] : c1[e & 3], sn = e < 4 ? s0[e & 3] : s1[e & 3]; v[e] = second ? v[e] * cs + pr * sn : v[e] * cs - pr * sn; }
                }
                if (pn < 2) {
#pragma unroll
                    for (int e = 0; e < 8; ++e) v[e] *= QSCALE;
                    store8_bf16(QA + (size_t)row * 512 + col, v);
                } else store8_bf16(KC + (size_t)(b * KEYS + (ctx ? t : CTX + t)) * 512 + (col - 512), v);
                asm volatile("" ::: "memory"); });
        } else if (pn < 6) {
            epi_for_each(acc, u, wr, wc, fr, fq, [&](int row, int col, float* v) __attribute__((always_inline)) {
                int b, t; if (ctx) { const int rc = row - MLAT; b = rc >> 8; t = rc & 255; } else { b = row >> 11; t = row & 2047; }
                store8_bf16(VT + (size_t)(b * KEYS + (ctx ? t : CTX + t)) * 512 + (col - 1024), v);
                asm volatile("" ::: "memory"); });
        } else if (pn == 7 || pn == 8) {
            const float* lbp0 = lb + (pn == 7 ? 0 : 256) - (pn == 7 ? 1792 : 2048); float* G0 = (pn == 7 ? GF : GB) - (pn == 7 ? 1792 : 2048);
            epi_for_each(acc, u, wr, wc, fr, fq, [&](int row, int col, float* v) __attribute__((always_inline)) {
                const float* lbp = lbp0 + col; float* G = G0 + (size_t)row * 256 + col;
                (void)lbp; f32x4 o0, o1;
#pragma unroll
                for (int e = 0; e < 4; ++e) { o0[e] = v[e]; o1[e] = v[4 + e]; }
                *(f32x4*)G = o0; *(f32x4*)(G + 4) = o1;
                asm volatile("" ::: "memory"); });
        } else {
            bf16_t* dst = pn == 6 ? QH : pn == 9 ? VH : pn == 10 ? OG : UU; const int c0 = pn * 256; const bool act = pn == 10;
            epi_for_each(acc, u, wr, wc, fr, fq, [&](int row, int col, float* v) __attribute__((always_inline)) {
                if (act) {
#pragma unroll
                    for (int e = 0; e < 8; ++e) v[e] = silu_f(v[e]);
                }
                store8_bf16(dst + (size_t)row * 256 + (col - c0), v);
                asm volatile("" ::: "memory"); });
        }
    }
};


constexpr int KS_STRIDE = 272, VS_STRIDE = 320;
constexpr int ATT_KBUF = 64 * KS_STRIDE, ATT_VBUF = 64 * VS_STRIDE;
constexpr int ATT_LDS = 2 * ATT_KBUF + 2 * ATT_VBUF;
typedef short v4i16_t __attribute__((ext_vector_type(4)));
struct AttnArgs { const bf16_t* QA; const bf16_t* KC; const bf16_t* VC; bf16_t* MIX; const float* lamp; const float* subw; int nlat, nunits; };
__device__ __forceinline__ void attn_unit(unsigned char* lds, const AttnArgs& A, int unit) {
    const int tid = tid_opaque(), lane = tid & 63, wid = tid >> 6, r32 = lane & 31, hi = lane >> 5;
    int b, h, qrow0, nkeys;
    if (unit < A.nlat) { b = unit >> 5; h = (unit >> 3) & 3; qrow0 = b * SEQ + (unit & 7) * 256; nkeys = KEYS; }
    else { const int uc = unit - A.nlat; b = uc >> 2; h = uc & 3; qrow0 = MLAT + b * CTX; nkeys = CTX; }
    const int nt = nkeys >> 6;
    const int qrow = qrow0 + wid * 32 + r32;
    bf16x8 qf[2][4];
    { const bf16_t* qp = A.QA + (size_t)qrow * 512 + h * 128 + hi * 8;
#pragma unroll
      for (int c = 0; c < 2; ++c)
#pragma unroll
          for (int s = 0; s < 4; ++s) qf[c][s] = *(const bf16x8*)(qp + c * 64 + s * 16); }
    const float lam = A.lamp[0];
    const int srow = tid >> 4, sch = tid & 15;
    const bf16_t* kg = A.KC + (size_t)(b * KEYS + srow) * 512 + h * 128 + sch * 8;
    const bf16_t* vg = A.VC + (size_t)(b * KEYS + srow) * 512 + h * 128 + sch * 8;
    const int kso = srow * KS_STRIDE + sch * 16, vso = srow * VS_STRIDE + sch * 16;
    u32x4 kr0, kr1, vr0, vr1;
#define ATT_GLOAD_K(t) do { kr0 = *(const u32x4*)(kg + (size_t)(t) * 64 * 512); kr1 = *(const u32x4*)(kg + (size_t)((t) * 64 + 32) * 512); } while (0)
#define ATT_GLOAD_V(t) do { vr0 = *(const u32x4*)(vg + (size_t)(t) * 64 * 512); vr1 = *(const u32x4*)(vg + (size_t)((t) * 64 + 32) * 512); } while (0)
#define ATT_LSTORE_K(buf) do { *(u32x4*)(lds + (buf) * ATT_KBUF + kso) = kr0; *(u32x4*)(lds + (buf) * ATT_KBUF + kso + 32 * KS_STRIDE) = kr1; } while (0)
#define ATT_LSTORE_V(buf) do { *(u32x4*)(lds + 2 * ATT_KBUF + (buf) * ATT_VBUF + vso) = vr0; *(u32x4*)(lds + 2 * ATT_KBUF + (buf) * ATT_VBUF + vso + 32 * VS_STRIDE) = vr1; } while (0)
    __syncthreads();
    ATT_GLOAD_K(0); ATT_LSTORE_K(0);
    __syncthreads();
    float m0 = -1e30f, m1 = -1e30f, l0 = 0.f, l1 = 0.f;
    for (int t = 0; t < nt; ++t) {
        const int buf = t & 1;
        if (t + 1 < nt) ATT_GLOAD_K(t + 1); else { ATT_GLOAD_K(0); ATT_GLOAD_V(0); }
#pragma unroll
        for (int kb = 0; kb < 2; ++kb) {
            f32x16 S0, S1;
#pragma unroll
            for (int r = 0; r < 16; ++r) { S0[r] = 0.f; S1[r] = 0.f; }
            const unsigned char* kp = lds + buf * ATT_KBUF + (kb * 32 + r32) * KS_STRIDE + hi * 16;
#pragma unroll
            for (int s = 0; s < 4; ++s) {
                const bf16x8 k0 = *(const bf16x8*)(kp + s * 32), k1 = *(const bf16x8*)(kp + 128 + s * 32);
                S0 = __builtin_amdgcn_mfma_f32_32x32x16_bf16(k0, qf[0][s], S0, 0, 0, 0);
                S1 = __builtin_amdgcn_mfma_f32_32x32x16_bf16(k1, qf[1][s], S1, 0, 0, 0);
            }
            float x0 = S0[0], x1 = S1[0];
#pragma unroll
            for (int r = 1; r < 16; ++r) { x0 = fmaxf(x0, S0[r]); x1 = fmaxf(x1, S1[r]); }
            x0 = fmaxf(x0, __shfl_xor(x0, 32)); x1 = fmaxf(x1, __shfl_xor(x1, 32));
            const float n0 = fmaxf(m0, x0), n1 = fmaxf(m1, x1);
            float a0 = 0.f, a1 = 0.f;
#pragma unroll
            for (int r = 0; r < 16; ++r) { a0 += __builtin_amdgcn_exp2f(S0[r] - n0); a1 += __builtin_amdgcn_exp2f(S1[r] - n1); }
            l0 = l0 * __builtin_amdgcn_exp2f(m0 - n0) + a0; l1 = l1 * __builtin_amdgcn_exp2f(m1 - n1) + a1; m0 = n0; m1 = n1;
        }
        ATT_LSTORE_K(buf ^ 1); if (t + 1 == nt) ATT_LSTORE_V(buf ^ 1);
        __syncthreads();
    }
    l0 += __shfl_xor(l0, 32); l1 += __shfl_xor(l1, 32);
    const float nM0 = -(m0 + __log2f(l0)), nM1 = -(m1 + __log2f(l1));
    f32x16 O[4];
#pragma unroll
    for (int d = 0; d < 4; ++d)
#pragma unroll
        for (int r = 0; r < 16; ++r) O[d][r] = 0.f;
    const int vlane = ((lane & 15) >> 2) * VS_STRIDE + (((lane >> 4) & 1) * 16 + (lane & 3) * 4) * 2 + 4 * hi * VS_STRIDE;
    for (int t = 0; t < nt; ++t) {
        const int buf = (nt + t) & 1;
        if (t + 1 < nt) { ATT_GLOAD_K(t + 1); ATT_GLOAD_V(t + 1); }
#pragma unroll
        for (int kb = 0; kb < 2; ++kb) {
            f32x16 S0, S1;
#pragma unroll
            for (int r = 0; r < 16; ++r) { S0[r] = nM0; S1[r] = nM1; }
            const unsigned char* kp = lds + buf * ATT_KBUF + (kb * 32 + r32) * KS_STRIDE + hi * 16;
#pragma unroll
            for (int s = 0; s < 4; ++s) {
                const bf16x8 k0 = *(const bf16x8*)(kp + s * 32), k1 = *(const bf16x8*)(kp + 128 + s * 32);
                S0 = __builtin_amdgcn_mfma_f32_32x32x16_bf16(k0, qf[0][s], S0, 0, 0, 0);
                S1 = __builtin_amdgcn_mfma_f32_32x32x16_bf16(k1, qf[1][s], S1, 0, 0, 0);
            }
            bf16x8 pa[2];
#pragma unroll
            for (int sp = 0; sp < 2; ++sp) { float a[8];
#pragma unroll
                for (int j = 0; j < 8; ++j) a[j] = __builtin_amdgcn_exp2f(S0[8 * sp + j]) - lam * __builtin_amdgcn_exp2f(S1[8 * sp + j]);
                u32x4 w; w.x = pk2(a[0], a[1]); w.y = pk2(a[2], a[3]); w.z = pk2(a[4], a[5]); w.w = pk2(a[6], a[7]);
                pa[sp] = __builtin_bit_cast(bf16x8, w); }
            const LAS unsigned char* vp = (const LAS unsigned char*)(lds + 2 * ATT_KBUF + buf * ATT_VBUF) + vlane + kb * 32 * VS_STRIDE;
#pragma unroll
            for (int d = 0; d < 4; ++d)
#pragma unroll
                for (int sp = 0; sp < 2; ++sp) {
                    const v4i16_t lo = __builtin_amdgcn_ds_read_tr16_b64_v4i16((LAS v4i16_t*)(vp + (16 * sp) * VS_STRIDE + d * 64));
                    const v4i16_t hh = __builtin_amdgcn_ds_read_tr16_b64_v4i16((LAS v4i16_t*)(vp + (16 * sp + 8) * VS_STRIDE + d * 64));
                    const bf16x8 vf = (bf16x8){lo[0], lo[1], lo[2], lo[3], hh[0], hh[1], hh[2], hh[3]};
                    O[d] = __builtin_amdgcn_mfma_f32_32x32x16_bf16(vf, pa[sp], O[d], 0, 0, 0);
                }
        }
        if (t + 1 < nt) { ATT_LSTORE_K(buf ^ 1); ATT_LSTORE_V(buf ^ 1); }
        __syncthreads();
    }
#undef ATT_GLOAD_K
#undef ATT_GLOAD_V
#undef ATT_LSTORE_K
#undef ATT_LSTORE_V
    float ss = 0.f;
#pragma unroll
    for (int d = 0; d < 4; ++d)
#pragma unroll
        for (int r = 0; r < 16; ++r) ss += O[d][r] * O[d][r];
    ss += __shfl_xor(ss, 32);
    const float sc = rsqrtf(ss * (1.f / 128.f) + EPS) * A.lamp[2];
    bf16_t* op = A.MIX + (size_t)qrow * DM + h * 128;
#pragma unroll
    for (int d = 0; d < 4; ++d)
#pragma unroll
        for (int g = 0; g < 4; ++g) { const int dv = d * 32 + 8 * g + 4 * hi; const f32x4 w = *(const f32x4*)(A.subw + dv);
            u32x2 pk; pk.x = pk2(O[d][4 * g] * sc * w[0], O[d][4 * g + 1] * sc * w[1]); pk.y = pk2(O[d][4 * g + 2] * sc * w[2], O[d][4 * g + 3] * sc * w[3]);
            *(u32x2*)(op + dv) = pk; }
}

struct P {
    const float *x, *c, *ctx, *c_ctx, *w_ada, *b_ada, *norm1_w, *norm2_w, *w_in, *lam_qk, *subln_w, *lb_param, *hgrn_norm_w, *w_fnet, *w_out, *w_up, *conv_w, *conv_b, *w_down, *final_norm_w;
    float* out; unsigned char* ws;
};
#define WSP(T, off) ((T*)(p.ws + (off)))

__device__ __forceinline__ void small_tables(const P& p) {
    const int tid = tid_opaque(); float* lam_out = WSP(float, WS_LAM); float* lb_out = WSP(float, WS_LB); float* rope = WSP(float, WS_ROPE);
    if (tid < 2) {
        const float* q = p.lam_qk + tid * 256; float s1 = 0.f, s2 = 0.f;
        for (int i = 0; i < 64; ++i) { s1 += q[i] * q[64 + i]; s2 += q[128 + i] * q[192 + i]; }
        const float lam_init = 0.8f - 0.6f * expf(-0.3f * (float)tid);
        lam_out[tid] = expf(s1) - expf(s2) + lam_init; lam_out[2 + tid] = 1.f - lam_init;
    }
    for (int i = tid; i < 512; i += 512) { const float p0 = p.lb_param[i], p1 = p.lb_param[512 + i]; lb_out[i] = 0.f; lb_out[512 + i] = 1.f / (1.f + expf(p0 - p1)); }
    for (int i = tid; i < 1024; i += 512) { const int pos = i >> 4, j = i & 15; const double f = pow(10000.0, -(double)j / 16.0), a = (double)pos * f; rope[i] = (float)cos(a); rope[1024 + i] = (float)sin(a); }
}
__device__ __forceinline__ void adaln_unit(const P& p, unsigned char* lds, int unit) {
    float (*cs)[1024] = (float (*)[1024])lds; float (*red)[9][64] = (float (*)[9][64])(lds + 9 * 1024 * 4);
    const int tid = tid_opaque(), li = unit / 96, nb = unit % 96, n = nb * 64 + (tid & 63), ks = tid >> 6; float* mod = WSP(float, WS_MOD);
    __syncthreads();
    for (int i = tid; i < 9 * 1024; i += 512) { const int r = i >> 10, k = i & 1023; const float v = r < 8 ? p.c[r * 1024 + k] : p.c_ctx[k]; cs[r][k] = silu_f(v); }
    __syncthreads();
    float acc[9];
#pragma unroll
    for (int r = 0; r < 9; ++r) acc[r] = 0.f;
    const float* W = p.w_ada + (size_t)li * 1024 * 6144 + n;
#pragma unroll 4
    for (int k = ks * 128; k < ks * 128 + 128; ++k) { const float w = W[(size_t)k * 6144];
#pragma unroll
        for (int r = 0; r < 9; ++r) acc[r] += cs[r][k] * w; }
#pragma unroll
    for (int r = 0; r < 9; ++r) red[ks][r][tid & 63] = acc[r];
    __syncthreads();
    for (int i = tid; i < 9 * 64; i += 512) { const int r = i >> 6, nn = i & 63; float s = p.b_ada[li * 6144 + nb * 64 + nn];
        for (int q = 0; q < 8; ++q) s += red[q][r][nn];
        mod[((size_t)li * 9 + r) * 6144 + nb * 64 + nn] = s; }
}
__device__ __forceinline__ void transpose_unit(const float* W, int N, bf16_t* WT, int KT, int nt64, int unit, int upperm, unsigned char* lds) {
    float (*t)[65] = (float (*)[65])lds;
    const int tid = tid_opaque(), k0 = (unit / nt64) * 32, n0 = (unit % nt64) * 64;
    __syncthreads();
    { const int tx = tid & 63, ty = tid >> 6; const int np = n0 + tx; int col = np;
      if (upperm) { const int tile = np >> 8, w = np & 255; col = w < 128 ? tile * 128 + w : DFF + tile * 128 + (w - 128); }
#pragma unroll
      for (int i = ty; i < 32; i += 8) t[i][tx] = W[(size_t)(k0 + i) * N + col]; }
    __syncthreads();
    { const int kx = tid & 31, ny = tid >> 5;
#pragma unroll
      for (int i = ny; i < 64; i += 16) WT[(size_t)(n0 + i) * KT + k0 + kx] = f2bf(t[kx][i]); }
}
__device__ __forceinline__ void fold_unit(const P& p, unsigned char* lds, int unit) {
    float (*wf)[256] = (float (*)[256])lds;
    const int tid = tid_opaque(), li = unit >> 7, it = (unit >> 4) & 7, nt = unit & 15, i0 = it * 32, n0 = nt * 64;
    __syncthreads();
    for (int i = tid; i < 32 * 256; i += 512) wf[i >> 8][i & 255] = p.w_fnet[((size_t)li * 256 + i0 + (i >> 8)) * 256 + (i & 255)];
    __syncthreads();
    const int ii = tid >> 4, n4 = (tid & 15) * 4; const float* wo = p.w_out + ((size_t)li * 1024 + 768) * 1024 + n0 + n4;
    f32x4 s = {0.f, 0.f, 0.f, 0.f};
    for (int j = 0; j < 256; ++j) { const f32x4 w = *(const f32x4*)(wo + (size_t)j * 1024); const float a = wf[ii][j]; s[0] += a * w[0]; s[1] += a * w[1]; s[2] += a * w[2]; s[3] += a * w[3]; }
    bf16_t* o = WSP(bf16_t, WS_WOUT) + (size_t)li * DM * DM + (size_t)(n0 + n4) * DM + 768 + i0 + ii;
#pragma unroll
    for (int e = 0; e < 4; ++e) o[(size_t)e * DM] = f2bf(s[e]);
}
__device__ __forceinline__ void dftgen_elem(bf16_t* A, int L, int idx) {
    const int lp = idx / L, kk = idx % L, h = L / 2; const int k = kk <= h ? kk : kk - h;
    const int ph = (int)(((long)k * lp) % L);
    float s, c; sincospif(2.0f * (float)ph / (float)L, &s, &c);
    const float sc = rsqrtf((float)L);
    A[idx] = f2bf(kk <= h ? c * sc : -s * sc);
}
constexpr int TU_WIN = (DM / 32) * (PW / 64), TU_WOUT = (768 / 32) * (DM / 64), TU_WUP = (DM / 32) * (2 * DFF / 64), TU_WDOWN = (DFF / 32) * (DM / 64);
__device__ __forceinline__ void ffn_weight_units(const P& p, unsigned char* lds, int li, int u) {
    if (u < TU_WUP) transpose_unit(p.w_up + (size_t)li * DM * 2 * DFF, 2 * DFF, WSP(bf16_t, WS_WUP), DM, 2 * DFF / 64, u, 1, lds);
    else transpose_unit(p.w_down + (size_t)li * DFF * DM, DM, WSP(bf16_t, WS_WDOWN), DFF, DM / 64, u - TU_WUP, 0, lds);
}
__device__ __forceinline__ void ph_prologue(const P& p, unsigned char* lds) {
    const int G = gridDim.x, bid = blockIdx.x;
    if (bid == G - 1) small_tables(p);
    for (int u = bid; u < 192; u += G) adaln_unit(p, lds, u);
    for (int u = bid; u < 256; u += G) fold_unit(p, lds, u);
    constexpr int NT = 2 * TU_WIN + 2 * TU_WOUT + TU_WUP + TU_WDOWN;
    for (int u = bid; u < NT; u += G) {
        int r = u;
        if (r < 2 * TU_WIN) { const int li = r / TU_WIN; transpose_unit(p.w_in + (size_t)li * DM * PW, PW, WSP(bf16_t, WS_WIN) + (size_t)li * PW * DM, DM, PW / 64, r % TU_WIN, 0, lds); continue; } r -= 2 * TU_WIN;
        if (r < 2 * TU_WOUT) { const int li = r / TU_WOUT; transpose_unit(p.w_out + (size_t)li * DM * DM, DM, WSP(bf16_t, WS_WOUT) + (size_t)li * DM * DM, DM, DM / 64, r % TU_WOUT, 0, lds); continue; } r -= 2 * TU_WOUT;
        ffn_weight_units(p, lds, 0, r);
    }
    for (int i = bid * 512 + tid_opaque(); i < SEQ * SEQ; i += G * 512) dftgen_elem(WSP(bf16_t, WS_DFT), SEQ, i);
    for (int i = bid * 512 + tid_opaque(); i < CTX * CTX; i += G * 512) dftgen_elem(WSP(bf16_t, WS_DFTC), CTX, i);
}

__device__ __forceinline__ void ph_normmod(const float* xlat, const float* xctx, const float* w, const float* mod, bf16_t* H, int shoff, int nrows) {
    const int lane = tid_opaque() & 63, wv = tid_opaque() >> 6;
    for (int row = blockIdx.x * 8 + wv; row < nrows; row += gridDim.x * 8) {
        const float* src = row < MLAT ? xlat + (size_t)row * DM : xctx + (size_t)(row - MLAT) * DM;
        const float* mv = mod + (size_t)(row < MLAT ? (row >> 11) : 8) * 6144 + shoff;
        f32x4 v[4]; float ss = 0.f;
#pragma unroll
        for (int j = 0; j < 4; ++j) { v[j] = *(const f32x4*)(src + (lane + 64 * j) * 4); ss += v[j][0] * v[j][0] + v[j][1] * v[j][1] + v[j][2] * v[j][2] + v[j][3] * v[j][3]; }
        const float rstd = rsqrtf(wave_sum(ss) * (1.f / DM) + EPS);
#pragma unroll
        for (int j = 0; j < 4; ++j) { const int c = (lane + 64 * j) * 4;
            const f32x4 wv4 = *(const f32x4*)(w + c), sh = *(const f32x4*)(mv + c), sc = *(const f32x4*)(mv + 1024 + c);
            float o[4];
#pragma unroll
            for (int e = 0; e < 4; ++e) o[e] = (v[j][e] * rstd * wv4[e]) * (1.f + sc[e]) + sh[e];
            u32x2 pk; pk.x = pk2(o[0], o[1]); pk.y = pk2(o[2], o[3]);
            *(u32x2*)(H + (size_t)row * DM + c) = pk; }
    }
}
__device__ __forceinline__ void ph_finalnorm(float* x, const float* w, int nrows) {
    const int lane = tid_opaque() & 63, wv = tid_opaque() >> 6;
    for (int row = blockIdx.x * 8 + wv; row < nrows; row += gridDim.x * 8) {
        float* src = x + (size_t)row * DM;
        f32x4 v[4]; float ss = 0.f;
#pragma unroll
        for (int j = 0; j < 4; ++j) { v[j] = *(const f32x4*)(src + (lane + 64 * j) * 4); ss += v[j][0] * v[j][0] + v[j][1] * v[j][1] + v[j][2] * v[j][2] + v[j][3] * v[j][3]; }
        const float rstd = rsqrtf(wave_sum(ss) * (1.f / DM) + EPS);
#pragma unroll
        for (int j = 0; j < 4; ++j) { const int c = (lane + 64 * j) * 4; const f32x4 wv4 = *(const f32x4*)(w + c);
            f32x4 o; for (int e = 0; e < 4; ++e) o[e] = v[j][e] * rstd * wv4[e];
            *(f32x4*)(src + c) = o; }
    }
}

template <class Epi> __device__ __forceinline__ void ph_gemm(unsigned char* lds, const pg8::Gemm& g, const Epi& E) {
    pg8::StaticOrder S; S.init(g.M, g.N, (int)gridDim.x, (int)blockIdx.x);
    pg8::gemm_phase<Epi, pg8::StaticOrder, true, true>((LAS unsigned char*)lds, g, S, E);
}

constexpr int LS = 72;
__device__ __forceinline__ int hg_row(int b, int dir, int cs, int i) {
    int q = cs * 64 + i;
    if (q < CTX) return MLAT + b * CTX + (dir ? CTX - 1 - q : q);
    q -= CTX; return b * SEQ + (dir ? SEQ - 1 - q : q);
}
__device__ __forceinline__ f32x4 mm_tile(const bf16_t* A, const bf16_t* Bt, int tm, int tn, int lane, f32x4 acc) {
    const int r = lane & 15, q = lane >> 4;
#pragma unroll
    for (int ks = 0; ks < 2; ++ks) {
        const bf16x8 a = *(const bf16x8*)(A + (tm * 16 + r) * LS + ks * 32 + q * 8), b = *(const bf16x8*)(Bt + (tn * 16 + r) * LS + ks * 32 + q * 8);
        acc = __builtin_amdgcn_mfma_f32_16x16x32_bf16(a, b, acc, 0, 0, 0);
    }
    return acc;
}
struct HgArgs { const bf16_t* QH; const bf16_t* VH; const bf16_t* OG; const float* GF; const float* GB; bf16_t* L; float* DC; bf16_t* MIX; const float* wn; const float* lb; };
__device__ __forceinline__ void ph_hgrn_h1(unsigned char* lds, const HgArgs& A, int nunits) {
    bf16_t* K2t = (bf16_t*)lds; bf16_t* Vt = K2t + 64 * LS; float (*part)[64] = (float (*)[64])(lds + 2 * 64 * LS * 2);
    const int tid = tid_opaque(), lane = tid & 63, wid = tid >> 6, d = tid & 63, p8 = tid >> 6;
    float zc[8], zn[8]; bf16_t vc[8], vn[8];
#define H1_LOAD(UNIT, Z, V) do { const int seq_ = (UNIT) / NCH, cs_ = (UNIT) % NCH, dir_ = seq_ & 1, bh_ = seq_ >> 1; const float* G_ = dir_ ? A.GB : A.GF; \
        _Pragma("unroll") for (int e = 0; e < 8; ++e) { const size_t o_ = (size_t)hg_row(bh_ >> 2, dir_, cs_, 8 * p8 + e) * 256 + (bh_ & 3) * 64 + d; Z[e] = G_[o_]; V[e] = A.VH[o_]; } } while (0)
    int unit = blockIdx.x;
    if (unit < nunits) H1_LOAD(unit, zc, vc);
    for (; unit < nunits; unit += gridDim.x) {
        const int seq = unit / NCH, dir = seq & 1, h = (seq >> 1) & 3;
        const bool more = unit + (int)gridDim.x < nunits;
        if (more) H1_LOAD(unit + (int)gridDim.x, zn, vn);
        const float lbv = A.lb[dir * 256 + h * 64 + d];
        float g[8], c[8];
#pragma unroll
        for (int e = 0; e < 8; ++e) g[e] = log_forget(zc[e], lbv);
        c[0] = g[0];
#pragma unroll
        for (int e = 1; e < 8; ++e) c[e] = c[e - 1] + g[e];
        __syncthreads();
        part[p8][d] = c[7];
        __syncthreads();
        float off = 0.f, tot = 0.f;
#pragma unroll
        for (int q = 0; q < 8; ++q) { const float x = part[q][d]; tot += x; if (q < p8) off += x; }
#pragma unroll
        for (int e = 0; e < 8; ++e) { const float cc = c[e] + off; const float k = 1.f - __expf(g[e]); K2t[d * LS + 8 * p8 + e] = f2bf(k * __expf(tot - cc)); }
#pragma unroll
        for (int e = 0; e < 8; ++e) Vt[d * LS + 8 * p8 + e] = vc[e];
        if (p8 == 0) A.DC[(size_t)unit * 64 + d] = __expf(tot);
        __syncthreads();
        const int tm = wid >> 1; bf16_t* Lp = A.L + (size_t)unit * 4096;
#pragma unroll
        for (int j = 0; j < 2; ++j) { const int tn = 2 * (wid & 1) + j; f32x4 acc = {0.f, 0.f, 0.f, 0.f};
            acc = mm_tile(Vt, K2t, tm, tn, lane, acc);
#pragma unroll
            for (int r = 0; r < 4; ++r) Lp[(tm * 16 + 4 * (lane >> 4) + r) * 64 + tn * 16 + (lane & 15)] = f2bf(acc[r]); }
        if (more) {
#pragma unroll
            for (int e = 0; e < 8; ++e) { zc[e] = zn[e]; vc[e] = vn[e]; } }
    }
#undef H1_LOAD
}
__device__ __forceinline__ void ph_hgrn_scan(bf16_t* L, const float* DC) {
    for (int idx = blockIdx.x * 512 + tid_opaque(); idx < 64 * 4096; idx += gridDim.x * 512) {
        const int seq = idx >> 12, e = idx & 4095, d = e & 63;
        float S = 0.f;
        for (int cs = 0; cs < NCH; ++cs) { const size_t o = ((size_t)seq * NCH + cs) * 4096 + e; const float lv = bf2f(L[o]); L[o] = f2bf(S); S = DC[((size_t)seq * NCH + cs) * 64 + d] * S + lv; }
    }
}
__device__ __forceinline__ void ph_hgrn_h3(unsigned char* lds, const HgArgs& A, int nlat, int nunits) {
    bf16_t* Q1 = (bf16_t*)lds; bf16_t* K1 = Q1 + 64 * LS; bf16_t* Q2 = K1 + 64 * LS; bf16_t* Vt = Q2 + 64 * LS; bf16_t* St = Vt + 64 * LS; bf16_t* Sm = St + 64 * LS;
    float (*part)[64] = (float (*)[64])(lds + 6 * 64 * LS * 2); float (*Ol)[65] = (float (*)[65])(lds + 6 * 64 * LS * 2 + 8 * 64 * 4);
    const int tid = tid_opaque(), lane = tid & 63, wid = tid >> 6, d = tid & 63, p8 = tid >> 6;
    float zc[8], zn[8]; bf16_t qc[8], qn[8], vc[8], vn[8], sc[8], sn[8];
#define H3_DECODE(UNIT, DIR, B_, H_, J_, CTX_, CS_) do { if ((UNIT) < nlat) { CTX_ = false; B_ = (UNIT) >> 7; H_ = ((UNIT) >> 5) & 3; J_ = (UNIT) & 31; } else { const int uc_ = (UNIT) - nlat; CTX_ = true; B_ = uc_ >> 4; H_ = (uc_ >> 2) & 3; J_ = uc_ & 3; } \
        CS_ = CTX_ ? ((DIR) ? 3 - J_ : J_) : ((DIR) ? 4 + 31 - J_ : 4 + J_); } while (0)
#define H3_LOAD(UNIT, DIR, Z, Q, V, S) do { int b_, h_, j_, cs_; bool cx_; H3_DECODE(UNIT, DIR, b_, h_, j_, cx_, cs_); const float* G_ = (DIR) ? A.GB : A.GF; \
        const bf16_t* Sp_ = A.L + ((size_t)((b_ * 4 + h_) * 2 + (DIR)) * NCH + cs_) * 4096; \
        _Pragma("unroll") for (int e = 0; e < 8; ++e) { const size_t o_ = (size_t)hg_row(b_, (DIR), cs_, 8 * p8 + e) * 256 + h_ * 64 + d; Z[e] = G_[o_]; Q[e] = A.QH[o_]; V[e] = A.VH[o_]; S[e] = Sp_[(8 * p8 + e) * 64 + d]; } } while (0)
    int unit = blockIdx.x;
    if (unit < nunits) H3_LOAD(unit, 0, zc, qc, vc, sc);
    for (; unit < nunits; unit += gridDim.x) {
        int b, h, J, cs0; bool ctx; H3_DECODE(unit, 0, b, h, J, ctx, cs0); (void)cs0;
        for (int dir = 0; dir < 2; ++dir) {
            const int nu = dir == 0 ? unit : unit + (int)gridDim.x, nd = dir ^ 1; const bool more = nu < nunits;
            if (more) H3_LOAD(nu, nd, zn, qn, vn, sn);
            const float lbv = A.lb[dir * 256 + h * 64 + d];
            float g[8], c[8];
#pragma unroll
            for (int e = 0; e < 8; ++e) g[e] = log_forget(zc[e], lbv);
            c[0] = g[0];
#pragma unroll
            for (int e = 1; e < 8; ++e) c[e] = c[e - 1] + g[e];
            __syncthreads();
            part[p8][d] = c[7];
            __syncthreads();
            float off = 0.f, R = 0.f;
#pragma unroll
            for (int q = 0; q < 8; ++q) { const float x = part[q][d]; if (q < 4) R += x; if (q < p8) off += x; }
#pragma unroll
            for (int e = 0; e < 8; ++e) { const int i = 8 * p8 + e; const float cc = c[e] + off, k = 1.f - __expf(g[e]), q = bf2f(qc[e]);
                Q1[i * LS + d] = f2bf(q * __expf(cc - R)); K1[i * LS + d] = f2bf(k * __expf(R - cc)); Q2[i * LS + d] = f2bf(q * __expf(cc));
                Vt[d * LS + i] = vc[e];
                St[i * LS + d] = sc[e]; }
            __syncthreads();
            const int tm = wid >> 1, q4 = lane >> 4, r16 = lane & 15;
#pragma unroll
            for (int j = 0; j < 2; ++j) { const int tn = 2 * (wid & 1) + j; f32x4 acc = {0.f, 0.f, 0.f, 0.f};
                acc = mm_tile(Q1, K1, tm, tn, lane, acc);
#pragma unroll
                for (int r = 0; r < 4; ++r) { const int t = tm * 16 + 4 * q4 + r, sidx = tn * 16 + r16; Sm[t * LS + sidx] = f2bf(sidx <= t ? acc[r] : 0.f); } }
            __syncthreads();
#pragma unroll
            for (int j = 0; j < 2; ++j) { const int tn = 2 * (wid & 1) + j; f32x4 acc = {0.f, 0.f, 0.f, 0.f};
                acc = mm_tile(Sm, Vt, tm, tn, lane, acc);
                acc = mm_tile(Q2, St, tm, tn, lane, acc);
#pragma unroll
                for (int r = 0; r < 4; ++r) { const int t = tm * 16 + 4 * q4 + r, v = tn * 16 + r16;
                    if (dir == 0) Ol[t][v] = acc[r]; else Ol[63 - t][v] += acc[r]; } }
            __syncthreads();
            if (more) {
#pragma unroll
                for (int e = 0; e < 8; ++e) { zc[e] = zn[e]; qc[e] = qn[e]; vc[e] = vn[e]; sc[e] = sn[e]; } }
        }
        {
            const int tk = tid >> 3, v0 = (tid & 7) * 8; const int row = ctx ? MLAT + b * CTX + J * 64 + tk : b * SEQ + J * 64 + tk;
            float o[8], ss = 0.f;
#pragma unroll
            for (int e = 0; e < 8; ++e) { o[e] = Ol[tk][v0 + e]; ss += o[e] * o[e]; }
            ss += __shfl_xor(ss, 1); ss += __shfl_xor(ss, 2); ss += __shfl_xor(ss, 4);
            const float rstd = rsqrtf(ss * (1.f / 64.f) + EPS);
            const u32x4 ogw = *(const u32x4*)(A.OG + (size_t)row * 256 + h * 64 + v0);
            const unsigned og[4] = {ogw.x, ogw.y, ogw.z, ogw.w};
#pragma unroll
            for (int e = 0; e < 8; ++e) { const float gt = __uint_as_float((e & 1) ? (og[e >> 1] & 0xffff0000u) : (og[e >> 1] << 16)); o[e] = o[e] * rstd * A.wn[v0 + e] * gt; }
            store8_bf16(A.MIX + (size_t)row * DM + 512 + h * 64 + v0, o);
        }
    }
#undef H3_LOAD
#undef H3_DECODE
}

constexpr int FS = 264;
constexpr int PREP_T = 32 * FS * 2;
__device__ __forceinline__ void dftprep_tables(unsigned char* lds) {
    bf16_t* Tc = (bf16_t*)(lds + PREP_T); bf16_t* Ts = Tc + 64 * LS;
    __syncthreads();
    for (int i = tid_opaque(); i < 4096; i += 512) { const int c = i >> 6, cp = i & 63, ph = (c * cp) & 63; float sn, cs; sincospif((float)ph / 32.f, &sn, &cs); Tc[c * LS + cp] = f2bf(cs * 0.125f); Ts[c * LS + cp] = f2bf(sn * 0.125f); }
    __syncthreads();
}
__device__ __forceinline__ void dftprep_unit(unsigned char* lds, const bf16_t* UU, int rowbase, int L, bf16_t* Bt, int unit) {
    bf16_t* F = (bf16_t*)lds; const bf16_t* Tc = (const bf16_t*)(lds + PREP_T); const bf16_t* Ts = Tc + 64 * LS;
    const int tid = tid_opaque(), lane = tid & 63, wid = tid >> 6, ntile = L / 32, b = unit / ntile, k0 = (unit % ntile) * 32, hL = L / 2;
    __syncthreads();
#pragma unroll
    for (int pass = 0; pass < 2; ++pass) { const int r = (tid >> 5) + 16 * pass, c8 = (tid & 31) * 8, kk = k0 + r, k = kk <= hL ? kk : kk - hL;
        const u32x4 a = *(const u32x4*)(UU + (size_t)(rowbase + b * L + k) * 256 + c8);
        u32x4 o = a;
        if (k != 0 && k != hL) { const u32x4 bb = *(const u32x4*)(UU + (size_t)(rowbase + b * L + L - k) * 256 + c8); const float sg = kk <= hL ? 1.f : -1.f;
            const unsigned aw[4] = {a.x, a.y, a.z, a.w}, bw[4] = {bb.x, bb.y, bb.z, bb.w}; unsigned ow[4];
#pragma unroll
            for (int e = 0; e < 4; ++e) ow[e] = pk2(__uint_as_float(aw[e] << 16) + sg * __uint_as_float(bw[e] << 16), __uint_as_float(aw[e] & 0xffff0000u) + sg * __uint_as_float(bw[e] & 0xffff0000u));
            o.x = ow[0]; o.y = ow[1]; o.z = ow[2]; o.w = ow[3]; }
        *(u32x4*)(F + r * FS + c8) = o; }
    __syncthreads();
    const int g = wid >> 1, half = wid & 1, r16 = lane & 15, q4 = lane >> 4;
    bf16x8 af[2];
#pragma unroll
    for (int ks = 0; ks < 2; ++ks) af[ks] = *(const bf16x8*)(F + (half * 16 + r16) * FS + g * 64 + ks * 32 + q4 * 8);
#pragma unroll
    for (int nt = 0; nt < 4; ++nt) { f32x4 dc = {0.f, 0.f, 0.f, 0.f}, ds = {0.f, 0.f, 0.f, 0.f};
#pragma unroll
        for (int ks = 0; ks < 2; ++ks) { const bf16x8 bc = *(const bf16x8*)(Tc + (nt * 16 + r16) * LS + ks * 32 + q4 * 8), bs = *(const bf16x8*)(Ts + (nt * 16 + r16) * LS + ks * 32 + q4 * 8);
            dc = __builtin_amdgcn_mfma_f32_16x16x32_bf16(af[ks], bc, dc, 0, 0, 0); ds = __builtin_amdgcn_mfma_f32_16x16x32_bf16(af[ks], bs, ds, 0, 0, 0); }
        const int kr = k0 + half * 16 + 4 * q4; float o[4];
#pragma unroll
        for (int e = 0; e < 4; ++e) o[e] = (kr + e) <= hL ? dc[e] : ds[e];
        u32x2 pk; pk.x = pk2(o[0], o[1]); pk.y = pk2(o[2], o[3]);
        *(u32x2*)(Bt + (size_t)(b * 256 + g * 64 + nt * 16 + r16) * L + kr) = pk; }
}

__device__ __forceinline__ void ph_convgate(const bf16_t* U, int nrows, int seqlen, const float* conv_w, const float* conv_b, bf16_t* G, int grow0) {
    for (int idx = blockIdx.x * 512 + tid_opaque(); idx < nrows * 352; idx += gridDim.x * 512) {
        const int r = idx / 352, j0 = (idx % 352) * 8;
        const int t = r % seqlen; const bool hp = t > 0, hn = t < seqlen - 1;
        const int cg = (j0 >> 7) * 256 + (j0 & 127), cv = cg + 128;
        float og[8];
        const bf16_t* up = U + (size_t)r * 5632;
        u32x4 z; z.x = z.y = z.z = z.w = 0u;
        const u32x4 g1 = *(const u32x4*)(up + cg), v1 = *(const u32x4*)(up + cv);
        const u32x4 g0 = hp ? *(const u32x4*)(up - 5632 + cg) : z, v0 = hp ? *(const u32x4*)(up - 5632 + cv) : z;
        const u32x4 g2 = hn ? *(const u32x4*)(up + 5632 + cg) : z, v2 = hn ? *(const u32x4*)(up + 5632 + cv) : z;
        const unsigned G0[4] = {g0.x, g0.y, g0.z, g0.w}, G1[4] = {g1.x, g1.y, g1.z, g1.w}, G2[4] = {g2.x, g2.y, g2.z, g2.w};
        const unsigned V0[4] = {v0.x, v0.y, v0.z, v0.w}, V1[4] = {v1.x, v1.y, v1.z, v1.w}, V2[4] = {v2.x, v2.y, v2.z, v2.w};
#pragma unroll
        for (int e = 0; e < 8; ++e) {
            const int jg = j0 + e, jv = DFF + j0 + e;
#define UNPK(W) __uint_as_float((e & 1) ? (W[e >> 1] & 0xffff0000u) : (W[e >> 1] << 16))
            const float a = conv_w[jg] * UNPK(G0) + conv_w[2 * DFF + jg] * UNPK(G1) + conv_w[4 * DFF + jg] * UNPK(G2) + conv_b[jg];
            const float c = conv_w[jv] * UNPK(V0) + conv_w[2 * DFF + jv] * UNPK(V1) + conv_w[4 * DFF + jv] * UNPK(V2) + conv_b[jv];
#undef UNPK
            og[e] = silu_f(a) * c;
        }
        store8_bf16(G + (size_t)(grow0 + r) * DFF + j0, og);
    }
}


extern __shared__ __attribute__((aligned(16))) unsigned char g_lds[];
constexpr int LDS_XB = pg8::STAGE_BYTES;
constexpr int LDS_EDGE = pg8::STAGE_BYTES + 256;
constexpr int LDS_BYTES = LDS_EDGE + 17 * 2 * 256 * 2;
constexpr int UP_LAT_TILES = NB * 9;
struct UpOrder : pg8::StaticOrder {
    __device__ __forceinline__ long a_off(int pm, size_t) const { const int row0 = pm < UP_LAT_TILES ? (pm / 9) * SEQ + 254 * (pm % 9) - 1 : MLAT + (pm - UP_LAT_TILES) * CTX; return (long)row0 * (DM * 2); }
};
__device__ __forceinline__ float dpp_shr1(float v) { return __builtin_bit_cast(float, __builtin_amdgcn_update_dpp(0, __builtin_bit_cast(int, v), 0x111, 0xf, 0xf, true)); }
__device__ __forceinline__ float dpp_shl1(float v) { return __builtin_bit_cast(float, __builtin_amdgcn_update_dpp(0, __builtin_bit_cast(int, v), 0x101, 0xf, 0xf, true)); }
struct EpiConvGate {
    static constexpr bool PERM = true, AFTER_DRAIN = false;
    bf16_t* G; const float* cw; const float* cb;
    __device__ __forceinline__ void operator()(const f32x4 (&acc)[2][2][4][2], const pg8::Unit& u, int wr, int wc, int fr, int fq) const {
        LAS unsigned char* eb = (LAS unsigned char*)g_lds + LDS_EDGE;
        int seqrow0, tbase, seqlen, rlo, rhi;
        if (u.pm < UP_LAT_TILES) { const int s = u.pm / 9, t = u.pm % 9; seqrow0 = s * SEQ; tbase = 254 * t - 1; seqlen = SEQ; rlo = 1; rhi = 254; }
        else { seqrow0 = MLAT + (u.pm - UP_LAT_TILES) * CTX; tbase = 0; seqlen = CTX; rlo = 0; rhi = 255; }
        const int colw = wc * 32 + fq * 8;
        unsigned ebo = (unsigned)((4 * wr * 2 * 256 + colw) * 2); asm volatile("" : "+v"(ebo));
        LAS unsigned char* const ebl = eb + ebo; LAS unsigned char* const ebw = ebl + (fr == 15 ? 512 : 0);
        if (fr == 0 || fr == 15) {
            const int which = fr == 15 ? 1 : 0;
#pragma unroll
            for (int ai = 0; ai < 2; ++ai)
#pragma unroll
                for (int m = 0; m < 4; ++m) {
#pragma unroll
                    for (int bj = 0; bj < 2; ++bj) { u32x4 w; w.x = pk2(acc[ai][bj][m][0][0], acc[ai][bj][m][0][1]); w.y = pk2(acc[ai][bj][m][0][2], acc[ai][bj][m][0][3]);
                        w.z = pk2(acc[ai][bj][m][1][0], acc[ai][bj][m][1][1]); w.w = pk2(acc[ai][bj][m][1][2], acc[ai][bj][m][1][3]);
                        *(LAS u32x4*)(ebw + ((8 * ai + m) * 2 * 256 + bj * 128) * 2) = w; } }
        }
        asm volatile("s_waitcnt lgkmcnt(0)" ::: "memory"); __builtin_amdgcn_s_barrier(); asm volatile("" ::: "memory");
#pragma unroll
        for (int n = 0; n < 2; ++n) {
            const int j = u.pn * 128 + colw + 4 * n;
            const f32x4 g0 = *(const f32x4*)(cw + j), g1 = *(const f32x4*)(cw + 2 * DFF + j), g2 = *(const f32x4*)(cw + 4 * DFF + j), gb = *(const f32x4*)(cb + j);
            const f32x4 v0 = *(const f32x4*)(cw + DFF + j), v1 = *(const f32x4*)(cw + 3 * DFF + j), v2 = *(const f32x4*)(cw + 5 * DFF + j), vb = *(const f32x4*)(cb + DFF + j);
#pragma unroll
            for (int ai = 0; ai < 2; ++ai)
#pragma unroll
                for (int m = 0; m < 4; ++m) {
                    const int blk = 8 * ai + 4 * wr + m, r = 16 * blk + fr, tpos = tbase + r;
                    constexpr int dummy = 0; (void)dummy; const int lb = 8 * ai + m;
                    const u32x2 pg = *(const LAS u32x2*)(ebl + (((lb - 1) * 2 + 1) * 256 + 4 * n) * 2), pv = *(const LAS u32x2*)(ebl + (((lb - 1) * 2 + 1) * 256 + 128 + 4 * n) * 2);
                    const u32x2 ng = *(const LAS u32x2*)(ebl + (((lb + 1) * 2 + 0) * 256 + 4 * n) * 2), nv = *(const LAS u32x2*)(ebl + (((lb + 1) * 2 + 0) * 256 + 128 + 4 * n) * 2);
                    const bool first = tpos == 0, lastp = tpos == seqlen - 1;
                    float o[4];
#pragma unroll
                    for (int e = 0; e < 4; ++e) {
                        const float cg = acc[ai][0][m][n][e], cv = acc[ai][1][m][n][e];
                        const unsigned wpg = e < 2 ? pg.x : pg.y, wpv = e < 2 ? pv.x : pv.y, wng = e < 2 ? ng.x : ng.y, wnv = e < 2 ? nv.x : nv.y;
                        const float epg = __uint_as_float((e & 1) ? (wpg & 0xffff0000u) : (wpg << 16)), epv = __uint_as_float((e & 1) ? (wpv & 0xffff0000u) : (wpv << 16));
                        const float eng = __uint_as_float((e & 1) ? (wng & 0xffff0000u) : (wng << 16)), env = __uint_as_float((e & 1) ? (wnv & 0xffff0000u) : (wnv << 16));
                        float sg = dpp_shr1(cg), sv = dpp_shr1(cv), lg = dpp_shl1(cg), lv = dpp_shl1(cv);
                        asm volatile("" : "+v"(sg), "+v"(sv), "+v"(lg), "+v"(lv));
                        float pgv = fr == 0 ? epg : sg, pvv = fr == 0 ? epv : sv;
                        float ngv = fr == 15 ? eng : lg, nvv = fr == 15 ? env : lv;
                        if (first) { pgv = 0.f; pvv = 0.f; }
                        if (lastp) { ngv = 0.f; nvv = 0.f; }
                        const float a = g0[e] * pgv + g1[e] * cg + g2[e] * ngv + gb[e];
                        const float c = v0[e] * pvv + v1[e] * cv + v2[e] * nvv + vb[e];
                        o[e] = silu_f(a) * c;
                    }
                    asm volatile("" : "+v"(o[0]), "+v"(o[1]), "+v"(o[2]), "+v"(o[3]));
                    if (r >= rlo && r <= rhi && tpos < seqlen) { u32x2 pk; pk.x = pk2(o[0], o[1]); pk.y = pk2(o[2], o[3]); *(u32x2*)(G + (size_t)(seqrow0 + tpos) * DFF + j) = pk; }
                    asm volatile("" ::: "memory");
                }
        }
    }
};

#define XB_TMO      128
#define XB_XCNT(j)  (256  + 64 * (j))
#define XB_XSUB(j)  (1280 + 64 * (j))
#define XB_XGEN(j)  (2304 + 64 * (j))
#define XB_TOP      3328
#define XB_TOPGEN   3392
#define XCD_BAR_WORDS 3456
#define XB_SPIN_CAP (1u << 18)

__device__ __forceinline__ unsigned xb_ld(unsigned* p)              { return __hip_atomic_load(p, __ATOMIC_RELAXED, __HIP_MEMORY_SCOPE_AGENT); }
__device__ __forceinline__ unsigned xb_add(unsigned* p, unsigned v) { return __hip_atomic_fetch_add(p, v, __ATOMIC_RELAXED, __HIP_MEMORY_SCOPE_AGENT); }
__device__ __forceinline__ unsigned xb_xcc_id() { return (unsigned)__builtin_amdgcn_s_getreg((3 << 11) | 20) & 0xFu; }
#define XB_SPIN(cond, bar) do { unsigned _sp = 0; while (cond) { __builtin_amdgcn_s_sleep(1); \
    if ((++_sp & 255u) == 0u) { if (xb_ld(&(bar)[XB_TMO])) break; if (_sp > XB_SPIN_CAP) { atomicAdd(&(bar)[XB_TMO], 1u); break; } } } } while (0)

struct XcdBarrier {
    unsigned* bar; unsigned x;
    volatile LAS unsigned* st;
};

__device__ __forceinline__ XcdBarrier xcd_barrier_post(unsigned* bar, volatile LAS unsigned* st) {
    XcdBarrier b; b.bar = bar; b.x = xb_xcc_id(); b.st = st;
    if (threadIdx.x == 0) (void)xb_add(&bar[XB_XCNT(b.x)], 1u);
    return b;
}
__device__ __forceinline__ void xcd_barrier_complete(unsigned* bar, unsigned x, unsigned& nloc, unsigned& nx) {
    const unsigned G = gridDim.x * gridDim.y * gridDim.z;
    unsigned sum, cnt, mine, sp = 0u;
    for (;;) {
        sum = 0u; cnt = 0u; mine = 0u;
#pragma unroll
        for (unsigned j = 0; j < 16; ++j) { const unsigned c = xb_ld(&bar[XB_XCNT(j)]); sum += c; cnt += (c > 0u) ? 1u : 0u; mine = (j == x) ? c : mine; }
        if (sum == G) break;
        __builtin_amdgcn_s_sleep(1);
        if ((++sp & 255u) == 0u) { if (xb_ld(&bar[XB_TMO])) break; if (sp > XB_SPIN_CAP) { atomicAdd(&bar[XB_TMO], 1u); break; } }
    }
    nloc = mine > 0u ? mine : 1u; nx = cnt > 0u ? cnt : 1u;
}

__device__ __forceinline__ void xcd_barrier(const XcdBarrier& b) {
    asm volatile("s_waitcnt vmcnt(0)" ::: "memory");
    __syncthreads();
    if (threadIdx.x == 0) {
        unsigned* bar = b.bar;
        __builtin_amdgcn_s_waitcnt(0);
        unsigned nloc = b.st[0], nx = b.st[1];
        if (nloc == 0u) { xcd_barrier_complete(bar, b.x, nloc, nx); b.st[0] = nloc; b.st[1] = nx; }
        const unsigned old = xb_add(&bar[XB_XSUB(b.x)], 1u);
        const unsigned gen = old / nloc;
        if (old + 1u == (gen + 1u) * nloc) {
            __builtin_amdgcn_fence(__ATOMIC_RELEASE, "agent");
            asm volatile("s_waitcnt vmcnt(0)" ::: "memory");
            const unsigned og = xb_add(&bar[XB_TOP], 1u);
            const unsigned tg = og / nx;
            if (og + 1u == (tg + 1u) * nx) xb_add(&bar[XB_TOPGEN], 1u);
            else XB_SPIN(xb_ld(&bar[XB_TOPGEN]) == tg, bar);
            __builtin_amdgcn_fence(__ATOMIC_ACQUIRE, "agent");
            xb_add(&bar[XB_XGEN(b.x)], 1u);
            asm volatile("s_waitcnt vmcnt(0)" ::: "memory");
        } else {
            XB_SPIN(xb_ld(&bar[XB_XGEN(b.x)]) == gen, bar);
            __builtin_amdgcn_fence(__ATOMIC_ACQUIRE, "agent");
            asm volatile("s_waitcnt vmcnt(0)" ::: "memory");
        }
    }
    __syncthreads();
}

#define REP_PRO 1
#define REP_NORM 1
#define REP_INPROJ 1
#define REP_A1 1
#define REP_H1 1
#define REP_PREP 1
#define REP_A2 1
#define REP_DFT 1
#define REP_H3 1
#define REP_UP 1
#define REP_CG 1
#define REP_SYNC 1
namespace cg = cooperative_groups;

__global__ void __launch_bounds__(512, 2) mega_fwd(P p) {
    unsigned char* const lds = g_lds;
    cg::grid_group grid = cg::this_grid();
    float* out = p.out;
    float* MOD = WSP(float, WS_MOD); float* LAM = WSP(float, WS_LAM); float* LB = WSP(float, WS_LB); float* ROPE = WSP(float, WS_ROPE); float* STATS = WSP(float, WS_STATS);
    bf16_t* WIN = WSP(bf16_t, WS_WIN); bf16_t* WOUT = WSP(bf16_t, WS_WOUT); bf16_t* WUP = WSP(bf16_t, WS_WUP); bf16_t* WDOWN = WSP(bf16_t, WS_WDOWN);
    bf16_t* DFT = WSP(bf16_t, WS_DFT); bf16_t* DFTC = WSP(bf16_t, WS_DFTC); float* CTXX = WSP(float, WS_CTXX); bf16_t* H = WSP(bf16_t, WS_H); bf16_t* MIX = H;
    bf16_t* QA = WSP(bf16_t, WS_QA); bf16_t* KC = WSP(bf16_t, WS_KC); bf16_t* VT = WSP(bf16_t, WS_VT); bf16_t* QH = WSP(bf16_t, WS_QH); bf16_t* VH = WSP(bf16_t, WS_VH);
    bf16_t* OG = WSP(bf16_t, WS_OG); bf16_t* UU = WSP(bf16_t, WS_UU); float* GF = WSP(float, WS_GF); float* GB = WSP(float, WS_GB);
    bf16_t* LBUF = WSP(bf16_t, WS_L); float* DC = WSP(float, WS_DC); bf16_t* BT = WSP(bf16_t, WS_BT); bf16_t* BTC = WSP(bf16_t, WS_BTC);
    bf16_t* GBUF = WSP(bf16_t, WS_G); bf16_t* UCH = WSP(bf16_t, WS_UCH);
    const int G = gridDim.x, bid = blockIdx.x;
    if (tid_opaque() < 64) ((LAS unsigned*)(lds + LDS_XB))[tid_opaque()] = 0u;
    __syncthreads();
    const XcdBarrier bar = xcd_barrier_post(WSP(unsigned, WS_CTL), (volatile LAS unsigned*)(lds + LDS_XB));

    for (int rep = 0; rep < REP_PRO; ++rep) ph_prologue(p, lds);
    grid.sync();
    for (int li = 0; li < 2; ++li) {
        const bool last = li == 1; const float* mod = MOD + (size_t)li * 9 * 6144;
        const float* xl = li == 0 ? p.x : (const float*)out; const float* xc = li == 0 ? p.ctx : (const float*)CTXX;
        for (int rep = 0; rep < REP_NORM; ++rep) ph_normmod(xl, xc, p.norm1_w + li * DM, mod, H, 0, MTOT);
        if (li == 1) for (int u = bid; u < TU_WUP + TU_WDOWN; u += G) ffn_weight_units(p, lds, 1, u);
        xcd_barrier(bar);
        { pg8::Gemm g{H, WIN + (size_t)li * PW * DM, MTOT, PW, DM, 0}; EpiInProj E{QA, KC, VT, QH, VH, OG, UU, GF, GB, ROPE, LB + li * 512}; for (int rep = 0; rep < REP_INPROJ; ++rep) ph_gemm(lds, g, E); }
        xcd_barrier(bar);
        const AttnArgs AA{QA, KC, VT, MIX, LAM + li, p.subln_w + li * 128, 256, last ? 256 : 288};
        const HgArgs HA{QH, VH, OG, GF, GB, LBUF, DC, MIX, p.hgrn_norm_w + li * 64, LB + li * 512};
        for (int rep = 0; rep < REP_H1; ++rep) ph_hgrn_h1(lds, HA, 64 * NCH);
        dftprep_tables(lds);
        for (int rep = 0; rep < REP_PREP; ++rep) for (int u = bid; u < NB * SEQ / 32; u += G) dftprep_unit(lds, UU, 0, SEQ, BT, u);
        if (!last) for (int u = bid; u < NB * CTX / 32; u += G) dftprep_unit(lds, UU, MLAT, CTX, BTC, u);
        xcd_barrier(bar);
        for (int rep = 0; rep < REP_A2; ++rep) for (int u = bid; u < AA.nunits; u += G) attn_unit(lds, AA, u);
        ph_hgrn_scan(LBUF, DC);
        __syncthreads();
        { pg8::Gemm g{DFT, BT, SEQ, NB * 256, SEQ, 0}; EpiDft E{MIX, 0, SEQ}; for (int rep = 0; rep < REP_DFT; ++rep) ph_gemm(lds, g, E); }
        if (!last) { pg8::Gemm g{DFTC, BTC, CTX, NB * 256, CTX, 0}; EpiDft E{MIX, MLAT, CTX}; ph_gemm(lds, g, E); }
        xcd_barrier(bar);
        for (int rep = 0; rep < REP_H3; ++rep) ph_hgrn_h3(lds, HA, 1024, last ? 1024 : 1024 + 128);
        for (int rep = 0; rep < REP_SYNC; ++rep) xcd_barrier(bar);
        const int Mff = last ? MLAT : MTOT;
        { pg8::Gemm g{MIX, WOUT + (size_t)li * DM * DM, Mff, DM, DM, 0}; EpiResid E{xl, xc, out, CTXX, mod, 2048, 0}; ph_gemm(lds, g, E); }
        xcd_barrier(bar);
        ph_normmod(out, CTXX, p.norm2_w + li * DM, mod, H, 3072, Mff);
        xcd_barrier(bar);
        { const int ntile = last ? UP_LAT_TILES : UP_LAT_TILES + NB;
          pg8::Gemm g{H, WUP, ntile * 256, 2 * DFF, DM, 0}; EpiConvGate E{GBUF, p.conv_w + (size_t)li * 3 * 2 * DFF, p.conv_b + (size_t)li * 2 * DFF};
          UpOrder S; S.init(g.M, g.N, G, bid);
          for (int rep = 0; rep < REP_UP; ++rep) pg8::gemm_phase<EpiConvGate, UpOrder, true, true>((LAS unsigned char*)lds, g, S, E); }
        xcd_barrier(bar);
        { pg8::Gemm g{GBUF, WDOWN, Mff, DM, DFF, 0}; EpiResid E{out, CTXX, out, CTXX, mod, 5120, 0}; ph_gemm(lds, g, E); }
        xcd_barrier(bar);
    }
    ph_finalnorm(out, p.final_norm_w, MLAT);
}

extern "C" void kernel_launch(void* const* d_in, const int* in_sizes, int n_in, void* d_out, int out_size, void* d_ws, size_t ws_size, hipStream_t stream) {
    static int grid = 0;
    if (grid == 0) {
        if (n_in != 20 || ws_size < WS_END || out_size != MLAT * DM) { fprintf(stderr, "kernel_launch: unexpected sizes (n_in %d, ws %zu, out %d)\n", n_in, ws_size, out_size); grid = -1; return; }
        int dev = 0, cus = 0, per_cu = 0;
        (void)hipGetDevice(&dev); (void)hipDeviceGetAttribute(&cus, hipDeviceAttributeMultiprocessorCount, dev);
        (void)hipFuncSetAttribute((const void*)mega_fwd, hipFuncAttributeMaxDynamicSharedMemorySize, LDS_BYTES);
        if (hipOccupancyMaxActiveBlocksPerMultiprocessor(&per_cu, (const void*)mega_fwd, 512, LDS_BYTES) != hipSuccess || per_cu < 1) { fprintf(stderr, "kernel_launch: occupancy query failed (%d)\n", per_cu); per_cu = 1; }
        (void)hipGetLastError();
        if (per_cu > 1) per_cu = 1;
        grid = cus * per_cu;
    }
    if (grid < 0) return;
    if (hipMemsetAsync(d_ws, 0, 64 * 1024, stream) != hipSuccess) { fprintf(stderr, "kernel_launch: hipMemsetAsync failed\n"); return; }
    P p{};
    const float** pp = (const float**)&p;
    for (int i = 0; i < 20; ++i) pp[i] = (const float*)d_in[i];
    p.out = (float*)d_out; p.ws = (unsigned char*)d_ws;
    void* args[] = {&p};
    hipError_t e = hipLaunchCooperativeKernel((const void*)mega_fwd, dim3(grid), dim3(512), args, LDS_BYTES, stream);
    if (e != hipSuccess) fprintf(stderr, "kernel_launch: cooperative launch failed: %s (grid %d)\n", hipGetErrorString(e), grid);
}
```
